# Optimizing an MI355X kernel written in HIP

```python
import jax, jax.numpy as jnp
from jax import lax
import numpy as np

D_MODEL = 2048
BATCH = 2
SEQ = 16384
DEPTH = 1

GRID_W = 64
CTX_LEN = 256
NA_HEADS = 16
NA_HEAD_DIM = 64
NA_WIDTH = NA_HEADS * NA_HEAD_DIM
WIN_H = 8
WIN_W = 16
GLA_HEADS = 4
GLA_KEY_DIM = D_MODEL // 2
GLA_VAL_DIM = D_MODEL
GLA_HEAD_K = GLA_KEY_DIM // GLA_HEADS
GLA_HEAD_V = GLA_VAL_DIM // GLA_HEADS
GATE_RANK = 16
GATE_NORMALIZER = 16.0
GLA_CHUNK = 64
N_DIRS = 2
ROPE_BASE = 10000.0
ROPE_PAIRS = GLA_HEAD_K // 4
GATE_WIDTH = GLA_HEADS * 2 * ROPE_PAIRS
COLS = (NA_WIDTH, NA_WIDTH, NA_WIDTH, NA_WIDTH,
        GLA_KEY_DIM, GLA_KEY_DIM, GLA_VAL_DIM, GLA_VAL_DIM, N_DIRS * GATE_RANK,
        D_MODEL, D_MODEL)
PROJ_WIDTH = sum(COLS)
DEEPNORM_ALPHA = (2 * DEPTH) ** 0.25
DEEPNORM_BETA = (8 * DEPTH) ** -0.25
LN_EPS = 1e-6
RMS_EPS = 1e-6

kernel_name = "hybrid_natten_gla_gated_merge_block"


def _layer_norm(x, g=None, b=None):
    xf = x.astype(jnp.float32)
    mu = jnp.mean(xf, axis=-1, keepdims=True)
    var = jnp.mean(jnp.square(xf - mu), axis=-1, keepdims=True)
    y = (xf - mu) * lax.rsqrt(var + LN_EPS)
    if g is not None:
        y = y * g.astype(jnp.float32) + b.astype(jnp.float32)
    return y.astype(x.dtype)


def _split_cols(p):
    idx, acc = [], 0
    for w in COLS[:-1]:
        acc += w
        idx.append(acc)
    return jnp.split(p, idx, axis=-1)


def _heads(t, h):
    return t.reshape(t.shape[:-1] + (h, t.shape[-1] // h))


def _neighborhood_attention(q, k, v, k_ctx, v_ctx, rpb):
    bsz, s, h, d = q.shape
    rows = s // GRID_W
    kh = min(WIN_H, rows)
    qg = q.reshape(bsz, rows, GRID_W, h, d) * (d ** -0.5)
    kg = k.reshape(bsz, rows, GRID_W, h, d)
    vg = v.reshape(bsz, rows, GRID_W, h, d)
    cols = jnp.arange(GRID_W)
    c_start = jnp.clip(cols - WIN_W // 2, 0, GRID_W - WIN_W)
    col_idx = c_start[:, None] + jnp.arange(WIN_W)[None, :]
    dc = col_idx - cols[:, None] + (WIN_W - 1)
    n_loc = kh * WIN_W

    def row_block(r):
        r_start = jnp.clip(r - kh // 2, 0, rows - kh)
        q_r = lax.dynamic_index_in_dim(qg, r, axis=1, keepdims=False)
        k_rows = lax.dynamic_slice_in_dim(kg, r_start, kh, axis=1)
        v_rows = lax.dynamic_slice_in_dim(vg, r_start, kh, axis=1)
        k_win = k_rows[:, :, col_idx]
        v_win = v_rows[:, :, col_idx]
        dr = r_start + jnp.arange(kh) - r + (WIN_H - 1)
        bias = rpb[:, dr[:, None, None], dc[None]]
        s_loc = jnp.einsum('bqhd,biqjhd->bhqij', q_r, k_win) + bias.transpose(0, 2, 1, 3)[None]
        s_ctx = jnp.einsum('bqhd,bkhd->bhqk', q_r, k_ctx)
        scores = jnp.concatenate([s_loc.reshape(bsz, h, GRID_W, n_loc), s_ctx], axis=-1)
        p = jax.nn.softmax(scores.astype(jnp.float32), axis=-1).astype(v.dtype)
        p_loc = p[..., :n_loc].reshape(bsz, h, GRID_W, kh, WIN_W)
        p_ctx = p[..., n_loc:]
        return (jnp.einsum('bhqij,biqjhd->bqhd', p_loc, v_win)
                + jnp.einsum('bhqk,bkhd->bqhd', p_ctx, v_ctx))

    o = lax.map(row_block, jnp.arange(rows))
    return o.transpose(1, 0, 2, 3, 4).reshape(bsz, s, h * d)


def _context_attention(q, k, v):
    d = q.shape[-1]
    scores = jnp.einsum('bqhd,bkhd->bhqk', q * (d ** -0.5), k)
    p = jax.nn.softmax(scores.astype(jnp.float32), axis=-1).astype(v.dtype)
    o = jnp.einsum('bhqk,bkhd->bqhd', p, v)
    return o.reshape(o.shape[:2] + (-1,))


def _axial_rope(x, row, col):
    inv_freq = ROPE_BASE ** (-jnp.arange(ROPE_PAIRS, dtype=jnp.float32) / ROPE_PAIRS)

    def rot(u, pos):
        ang = pos[:, None] * inv_freq[None, :]
        cos = jnp.cos(ang)[None, :, None, :]
        sin = jnp.sin(ang)[None, :, None, :]
        u1, u2 = u[..., :ROPE_PAIRS], u[..., ROPE_PAIRS:]
        return jnp.concatenate([u1 * cos - u2 * sin, u1 * sin + u2 * cos], axis=-1)

    half = x.shape[-1] // 2
    return jnp.concatenate([rot(x[..., :half], row), rot(x[..., half:], col)], axis=-1)


def _gla_log_decay(bg, w_gate2, b_gate):
    lr = bg.reshape(bg.shape[:-1] + (N_DIRS, GATE_RANK)).astype(jnp.float32)
    g = jnp.einsum('btdr,drk->btdk', lr, w_gate2.astype(jnp.float32)) + b_gate.astype(jnp.float32)
    g = jax.nn.log_sigmoid(g) / GATE_NORMALIZER
    g = g.reshape(g.shape[:3] + (GLA_HEADS, 2, ROPE_PAIRS))
    g = jnp.concatenate([g, g], axis=-1).reshape(g.shape[:3] + (GLA_HEADS, GLA_HEAD_K))
    return g[:, :, 0], g[:, :, 1]


def _gla_chunked(q, k, v, g, s0):
    bsz, t, h, _ = q.shape
    dv = v.shape[-1]
    n = t // GLA_CHUNK

    def chunks(a):
        return a.reshape(bsz, n, GLA_CHUNK, h, a.shape[-1]).transpose(1, 0, 3, 2, 4)

    tril = jnp.tril(jnp.ones((GLA_CHUNK, GLA_CHUNK), jnp.float32))

    def step(s, inp):
        qc, kc, vc, gc = inp
        cum = jnp.cumsum(gc, axis=2)
        last = cum[:, :, -1:]
        q_e = qc * jnp.exp(cum)
        k_e = kc * jnp.exp(-cum)
        att = jnp.einsum('bhik,bhjk->bhij', q_e, k_e) * tril
        o = jnp.einsum('bhij,bhjv->bhiv', att, vc) + jnp.einsum('bhik,bhkv->bhiv', q_e, s)
        s = (jnp.exp(last[:, :, 0])[..., None] * s
             + jnp.einsum('bhjk,bhjv->bhkv', kc * jnp.exp(last - cum), vc))
        return s, o

    s, o = lax.scan(step, s0, (chunks(q), chunks(k), chunks(v), chunks(g)))
    return o.transpose(1, 0, 3, 2, 4).reshape(bsz, t, h, dv), s


def _head_rms(o, g):
    y = o * lax.rsqrt(jnp.mean(jnp.square(o), axis=-1, keepdims=True) + RMS_EPS) * g.astype(jnp.float32)
    return y.reshape(y.shape[:2] + (-1,))


def _gla_mixer(bq, bk, bv, bg, bq_c, bk_c, bv_c, bg_c, w_gate2, b_gate, norm_g, need_ctx_out):
    f32 = jnp.float32
    t = bq.shape[1]
    pos = jnp.arange(t)
    row = (pos // GRID_W).astype(f32)
    col = (pos % GRID_W).astype(f32)
    scale = GLA_HEAD_K ** -0.5
    q = _axial_rope(_heads(bq.astype(f32), GLA_HEADS) * scale, row, col)
    k = _axial_rope(_heads(bk.astype(f32), GLA_HEADS), row, col)
    v = _heads(bv.astype(f32), GLA_HEADS)
    g_f, g_b = _gla_log_decay(bg, w_gate2, b_gate)
    qc = _heads(bq_c.astype(f32), GLA_HEADS) * scale
    kc = _heads(bk_c.astype(f32), GLA_HEADS)
    vc = _heads(bv_c.astype(f32), GLA_HEADS)
    gc_f, gc_b = _gla_log_decay(bg_c, w_gate2, b_gate)
    s0 = jnp.zeros((q.shape[0], GLA_HEADS, GLA_HEAD_K, GLA_HEAD_V), f32)

    def flip(a):
        return a[:, ::-1]

    oc_f, s_f = _gla_chunked(qc, kc, vc, gc_f, s0)
    oc_b, s_b = _gla_chunked(flip(qc), flip(kc), flip(vc), flip(gc_b), s0)
    o_f, _ = _gla_chunked(q, k, v, g_f, s_f)
    o_b, _ = _gla_chunked(flip(q), flip(k), flip(v), flip(g_b), s_b)
    y = _head_rms(o_f + flip(o_b), norm_g).astype(bv.dtype)
    y_c = _head_rms(oc_f + flip(oc_b), norm_g).astype(bv.dtype) if need_ctx_out else None
    return y, y_c


def _merge_branches(y_a, az, y_b, bz, mga, mgb, w_br_a, w_br_b, w_out):
    p_a = (y_a * jax.nn.silu(az)) @ w_br_a
    p_b = (y_b * jax.nn.silu(bz)) @ w_br_b
    return (jax.nn.sigmoid(mga) * p_a + jax.nn.sigmoid(mgb) * p_b) @ w_out


def setup_inputs(seed: int = 0) -> dict:
    key = jax.random.key(seed)
    ks = jax.random.split(key, 16)
    nrm = jax.random.normal
    f32 = jnp.float32
    return {
        "x": nrm(ks[0], (BATCH, SEQ, D_MODEL), f32),
        "c": nrm(ks[1], (BATCH, D_MODEL), f32),
        "ctx": nrm(ks[2], (BATCH, CTX_LEN, D_MODEL), f32),
        "c_ctx": nrm(ks[3], (D_MODEL,), f32),
        "w_mod": nrm(ks[4], (DEPTH, D_MODEL, 3 * D_MODEL), f32) * D_MODEL ** -0.5,
        "b_mod": 0.02 * nrm(ks[5], (DEPTH, 3 * D_MODEL), f32),
        "w_in": nrm(ks[6], (DEPTH, D_MODEL, PROJ_WIDTH), f32) * D_MODEL ** -0.5,
        "na_rpb": 0.1 * nrm(ks[7], (DEPTH, NA_HEADS, 2 * WIN_H - 1, 2 * WIN_W - 1), f32),
        "gla_w_gate2": nrm(ks[8], (DEPTH, N_DIRS, GATE_RANK, GATE_WIDTH), f32) * GATE_RANK ** -0.5,
        "gla_b_gate": 0.1 * nrm(ks[9], (DEPTH, N_DIRS, GATE_WIDTH), f32),
        "gla_norm_g": 1.0 + 0.02 * nrm(ks[10], (DEPTH, GLA_HEAD_V), f32),
        "w_br_a": nrm(ks[11], (DEPTH, NA_WIDTH, D_MODEL), f32) * NA_WIDTH ** -0.5 * DEEPNORM_BETA,
        "w_br_b": nrm(ks[12], (DEPTH, GLA_VAL_DIM, D_MODEL), f32) * GLA_VAL_DIM ** -0.5 * DEEPNORM_BETA,
        "w_out": nrm(ks[13], (DEPTH, D_MODEL, D_MODEL), f32) * D_MODEL ** -0.5 * DEEPNORM_BETA,
        "ln_g": 1.0 + 0.02 * nrm(ks[14], (DEPTH, D_MODEL), f32),
        "ln_b": 0.02 * nrm(ks[15], (DEPTH, D_MODEL), f32),
    }


def reference(x, c, ctx, c_ctx, w_mod, b_mod, w_in, na_rpb, gla_w_gate2, gla_b_gate,
              gla_norm_g, w_br_a, w_br_b, w_out, ln_g, ln_b):
    for l in range(DEPTH):
        update_ctx = l < DEPTH - 1
        mod = jax.nn.silu(c) @ w_mod[l] + b_mod[l]
        shift, scale, gate = jnp.split(mod[:, None, :], 3, axis=-1)
        mod_c = jax.nn.silu(c_ctx) @ w_mod[l] + b_mod[l]
        shift_c, scale_c, gate_c = jnp.split(mod_c, 3, axis=-1)
        h = _layer_norm(x) * (1.0 + scale) + shift
        h_c = _layer_norm(ctx) * (1.0 + scale_c) + shift_c
        aq, ak, av, az, bq, bk, bv, bz, bg, mga, mgb = _split_cols(h @ w_in[l])
        aq_c, ak_c, av_c, az_c, bq_c, bk_c, bv_c, bz_c, bg_c, mga_c, mgb_c = _split_cols(h_c @ w_in[l])
        k_ctx = _heads(ak_c, NA_HEADS)
        v_ctx = _heads(av_c, NA_HEADS)
        y_a = _neighborhood_attention(_heads(aq, NA_HEADS), _heads(ak, NA_HEADS), _heads(av, NA_HEADS),
                                      k_ctx, v_ctx, na_rpb[l])
        y_b, y_b_c = _gla_mixer(bq, bk, bv, bg, bq_c, bk_c, bv_c, bg_c,
                                gla_w_gate2[l], gla_b_gate[l], gla_norm_g[l], update_ctx)
        out = _merge_branches(y_a, az, y_b, bz, mga, mgb, w_br_a[l], w_br_b[l], w_out[l])
        x_new = _layer_norm(DEEPNORM_ALPHA * x + gate * out, ln_g[l], ln_b[l])
        if update_ctx:
            y_a_c = _context_attention(_heads(aq_c, NA_HEADS), k_ctx, v_ctx)
            out_c = _merge_branches(y_a_c, az_c, y_b_c, bz_c, mga_c, mgb_c, w_br_a[l], w_br_b[l], w_out[l])
            ctx = _layer_norm(DEEPNORM_ALPHA * ctx + gate_c * out_c, ln_g[l], ln_b[l])
        x = x_new
    return x
```

```cpp
#include <hip/hip_runtime.h>
#include <hip/hip_cooperative_groups.h>
#include <cstdio>
#include <cstdint>
namespace cg = cooperative_groups;

namespace pg8 {
#define PG8_LAS __attribute__((address_space(3)))
typedef unsigned short bf16_t;
typedef short bf16x8 __attribute__((ext_vector_type(8)));
typedef float f32x4 __attribute__((ext_vector_type(4)));
typedef unsigned u32x4 __attribute__((ext_vector_type(4)));
constexpr int BM = 256, BK = 64, HALF = 128, HTB = HALF * BK * 2  , STAGE_BYTES = 8 * HTB, NXCD = 8, WGM = 8;

__host__ __device__ __forceinline__ int lds_byte(int r, int c) { const int st = (r >> 4) * 2 + (c >> 5), rr = r & 15, cc = c & 31, ob = rr * 64 + cc * 2; return st * 1024 + (ob ^ (((ob >> 9) & 1) << 5)); }
__host__ __device__ __forceinline__ void stage_rc(int b, int& R, int& C) { const int st = b / 1024, sb = b % 1024, swz = sb ^ (((sb >> 9) & 1) << 5); R = (st >> 1) * 16 + swz / 64; C = (st & 1) * 32 + (swz % 64) / 2; }
__host__ __device__ __forceinline__ int perm32(int rho) { const int n = rho >> 4, i = rho & 15; return 8 * (i >> 2) + 4 * n + (i & 3); }

struct Unit { int pm, pn; };
struct Gemm { const bf16_t* A; const bf16_t* Bt; int M, N, K; };

struct StaticOrder {
    int nM, nN, nwg, G, c;
    __host__ __device__ void init(int M, int N, int G_, int c_) { nM = M / BM; nN = N / BM; nwg = nM * nN; G = G_; c = c_; }
    __host__ __device__ bool next(int i, Unit& u) const {
        const long L = (long)i * G + c; if (L >= nwg) return false;
        int wgid = (int)L; { const int q = nwg / NXCD, r = nwg % NXCD, xcd = wgid % NXCD, off = wgid / NXCD; wgid = (xcd < r ? xcd * (q + 1) : r * (q + 1) + (xcd - r) * q) + off; }
        const int nig = WGM * nN, gid = wgid / nig, fm = gid * WGM, gsz = (nM - fm) < WGM ? (nM - fm) : WGM;
        u.pm = fm + ((wgid % nig) % gsz); u.pn = (wgid % nig) / gsz; return true;
    }
    __device__ __forceinline__ void a_ready(const Unit&) const {}
    __device__ __forceinline__ void done(const Unit&) const {}
};

__device__ __forceinline__ unsigned cvt_pk_bf16(float lo, float hi) { unsigned r; asm volatile("v_cvt_pk_bf16_f32 %0, %1, %2" : "=v"(r) : "v"(lo), "v"(hi)); return r; }

template <class Epi, class Sched, bool ALIGN_EPI = false, bool SP2 = false>
__device__ __forceinline__ void gemm_phase(PG8_LAS unsigned char* lds, const Gemm g, const Sched& S, const Epi& E) {
    const int tid = threadIdx.x, wid = __builtin_amdgcn_readfirstlane(tid >> 6), lane = tid & 63, wr = wid >> 2, wc = wid & 3, fr = lane & 15, fq = lane >> 4;
    const int K = g.K, nt = K / BK;
    unsigned voffA[2], voffB[2];
#pragma unroll
    for (int i = 0; i < 2; ++i) { int R, C; stage_rc(tid * 16 + i * 8192, R, C); const int Rb = Epi::PERM ? ((R & ~31) + perm32(R & 31)) : R;
        voffA[i] = (unsigned)(R * K + C) * 2u; voffB[i] = (unsigned)(Rb * K + C) * 2u; }
    const size_t kstep = (size_t)(BK * 2);
    const size_t hstep = (size_t)HALF * K * 2;
    const size_t tstep = 2 * hstep;
    const unsigned ldsw = (unsigned)wid * 1024u;
    const int aoff = lds_byte(wr * 64 + fr, fq * 8), boff = lds_byte(wc * 32 + fr, fq * 8);
#define PG8_SA(b, h) (((b) * 2 + (h)) * HTB)
#define PG8_SB(b, h) ((4 + (b) * 2 + (h)) * HTB)
#define PG8_STAGE(bufoff, gbase, voff) do { _Pragma("unroll") for (int _i = 0; _i < 2; ++_i) \
        __builtin_amdgcn_global_load_lds((const unsigned*)((const char*)(gbase) + (voff)[_i]), (PG8_LAS unsigned*)(lds + (bufoff) + ldsw + _i * 8192), 16, 0, 0); } while (0)
#define PG8_LDA(dst, b, h) do { _Pragma("unroll") for (int m = 0; m < 4; ++m) _Pragma("unroll") for (int k = 0; k < 2; ++k) dst[m][k] = *(const PG8_LAS bf16x8*)(lds + PG8_SA(b, h) + aoff + m * 2048 + k * 1024); } while (0)
#define PG8_LDB(dst, b, h) do { _Pragma("unroll") for (int n = 0; n < 2; ++n) _Pragma("unroll") for (int k = 0; k < 2; ++k) dst[n][k] = *(const PG8_LAS bf16x8*)(lds + PG8_SB(b, h) + boff + n * 2048 + k * 1024); } while (0)
#define PG8_MMA(ai, bj, At, Bt) do { __builtin_amdgcn_s_setprio(1); _Pragma("unroll") for (int m = 0; m < 4; ++m) _Pragma("unroll") for (int n = 0; n < 2; ++n) _Pragma("unroll") for (int k = 0; k < 2; ++k) \
        acc[ai][bj][m][n] = __builtin_amdgcn_mfma_f32_16x16x32_bf16(Bt[n][k], At[m][k], acc[ai][bj][m][n], 0, 0, 0); __builtin_amdgcn_s_setprio(0); } while (0)
#define PG8_WAIT_V(n) asm volatile("s_waitcnt vmcnt(" #n ")" ::: "memory")
#define PG8_WAIT_L(n) asm volatile("s_waitcnt lgkmcnt(" #n ")" ::: "memory")
#define PG8_BAR __builtin_amdgcn_s_barrier()
#define PG8_SCHED __builtin_amdgcn_sched_barrier(0)
    Unit cur, nxt; int ui = 0;
    if (!S.next(0, cur)) return;
    f32x4 acc[2][2][4][2];
#pragma unroll
    for (int a = 0; a < 2; ++a)
#pragma unroll
        for (int b = 0; b < 2; ++b)
#pragma unroll
            for (int m = 0; m < 4; ++m)
#pragma unroll
                for (int n = 0; n < 2; ++n) acc[a][b][m][n] = (f32x4){0.f, 0.f, 0.f, 0.f};
    bf16x8 At[4][2], B0[2][2], B1[2][2];
    const char* cA = (const char*)g.A + (size_t)cur.pm * tstep; const char* cB = (const char*)g.Bt + (size_t)cur.pn * tstep;
    S.a_ready(cur);
    if constexpr (SP2) {
        PG8_STAGE(PG8_SB(0, 0), cB, voffB); PG8_STAGE(PG8_SB(0, 1), cB + hstep, voffB); PG8_STAGE(PG8_SA(0, 0), cA, voffA); PG8_STAGE(PG8_SA(0, 1), cA + hstep, voffA);
        if (wr == 1) PG8_BAR;
        PG8_WAIT_V(2); PG8_BAR;
        PG8_STAGE(PG8_SB(1, 0), cB + kstep, voffB); PG8_STAGE(PG8_SA(1, 0), cA + kstep, voffA); PG8_STAGE(PG8_SB(1, 1), cB + hstep + kstep, voffB);
        PG8_WAIT_V(6); PG8_BAR;
    } else {
        PG8_STAGE(PG8_SB(0, 0), cB, voffB); PG8_STAGE(PG8_SA(0, 0), cA, voffA); PG8_STAGE(PG8_SB(0, 1), cB + hstep, voffB); PG8_STAGE(PG8_SA(0, 1), cA + hstep, voffA);
        if (wr == 1) PG8_BAR;
        PG8_WAIT_V(4); PG8_BAR;
        PG8_STAGE(PG8_SB(1, 0), cB + kstep, voffB); PG8_STAGE(PG8_SA(1, 0), cA + kstep, voffA); PG8_STAGE(PG8_SB(1, 1), cB + hstep + kstep, voffB);
        PG8_WAIT_V(6); PG8_BAR;
    }
    for (;;) {
        const bool has_next = S.next(ui + 1, nxt);
        const char* nA = has_next ? (const char*)g.A + (size_t)nxt.pm * tstep : cA; const char* nB = has_next ? (const char*)g.Bt + (size_t)nxt.pn * tstep : cB;
        for (int t = 0; t < nt; t += 2) {
            const bool last = (t == nt - 2);
            const char* a1 = cA + (size_t)(t + 1) * kstep;
            const char* a2 = last ? nA : cA + (size_t)(t + 2) * kstep; const char* b2 = last ? nB : cB + (size_t)(t + 2) * kstep;
            const char* a3 = a2 + kstep; const char* b3 = b2 + kstep;
            if (last && has_next) S.a_ready(nxt);
            if constexpr (SP2) {
            PG8_LDB(B0, 0, 0); PG8_LDB(B1, 0, 1); PG8_SCHED; PG8_LDA(At, 0, 0); PG8_STAGE(PG8_SA(1, 1), a1 + hstep, voffA);
            PG8_WAIT_V(8); PG8_WAIT_L(0); PG8_BAR; PG8_MMA(0, 0, At, B0); PG8_MMA(0, 1, At, B1); PG8_BAR; PG8_SCHED;
            PG8_LDA(At, 0, 1); PG8_STAGE(PG8_SB(0, 0), b2, voffB); PG8_STAGE(PG8_SB(0, 1), b2 + hstep, voffB); PG8_STAGE(PG8_SA(0, 0), a2, voffA);
            PG8_WAIT_V(8); PG8_WAIT_L(0); PG8_BAR; PG8_MMA(1, 0, At, B0); PG8_MMA(1, 1, At, B1); PG8_BAR; PG8_SCHED;
            PG8_LDB(B0, 1, 0); PG8_LDB(B1, 1, 1); PG8_SCHED; PG8_LDA(At, 1, 0); PG8_STAGE(PG8_SA(0, 1), a2 + hstep, voffA);
            PG8_WAIT_V(8); PG8_WAIT_L(0); PG8_BAR; PG8_MMA(0, 0, At, B0); PG8_MMA(0, 1, At, B1); PG8_BAR; PG8_SCHED;
            PG8_LDA(At, 1, 1); PG8_STAGE(PG8_SB(1, 0), b3, voffB); PG8_STAGE(PG8_SB(1, 1), b3 + hstep, voffB); PG8_STAGE(PG8_SA(1, 0), a3, voffA);
            PG8_WAIT_V(8); PG8_WAIT_L(0); PG8_BAR; PG8_MMA(1, 0, At, B0); PG8_MMA(1, 1, At, B1); PG8_BAR; PG8_SCHED;
            } else {
            PG8_LDB(B0, 0, 0); PG8_SCHED; PG8_LDA(At, 0, 0); PG8_STAGE(PG8_SA(1, 1), a1 + hstep, voffA);
            PG8_WAIT_L(8); PG8_BAR; PG8_WAIT_L(0); PG8_MMA(0, 0, At, B0); PG8_BAR; PG8_SCHED;
            PG8_LDB(B1, 0, 1); PG8_STAGE(PG8_SB(0, 0), b2, voffB);
            PG8_BAR; PG8_WAIT_L(0); PG8_MMA(0, 1, At, B1); PG8_BAR;
            PG8_LDA(At, 0, 1); PG8_STAGE(PG8_SA(0, 0), a2, voffA);
            PG8_BAR; PG8_WAIT_L(0); PG8_MMA(1, 0, At, B0); PG8_BAR; PG8_SCHED;
            PG8_STAGE(PG8_SB(0, 1), b2 + hstep, voffB);
            PG8_WAIT_V(6); PG8_BAR; PG8_MMA(1, 1, At, B1); PG8_BAR;
            PG8_LDB(B0, 1, 0); PG8_SCHED; PG8_LDA(At, 1, 0); PG8_STAGE(PG8_SA(0, 1), a2 + hstep, voffA);
            PG8_WAIT_L(8); PG8_BAR; PG8_WAIT_L(0); PG8_MMA(0, 0, At, B0); PG8_BAR; PG8_SCHED;
            PG8_LDB(B1, 1, 1); PG8_STAGE(PG8_SB(1, 0), b3, voffB);
            PG8_BAR; PG8_WAIT_L(0); PG8_MMA(0, 1, At, B1); PG8_BAR;
            PG8_LDA(At, 1, 1); PG8_STAGE(PG8_SA(1, 0), a3, voffA);
            PG8_BAR; PG8_WAIT_L(0); PG8_MMA(1, 0, At, B0); PG8_BAR; PG8_SCHED;
            PG8_STAGE(PG8_SB(1, 1), b3 + hstep, voffB);
            PG8_WAIT_V(6); PG8_BAR; PG8_MMA(1, 1, At, B1); PG8_BAR;
            }
        }
        if constexpr (ALIGN_EPI) { if (wr == 0) PG8_BAR; }
        if constexpr (!Epi::AFTER_DRAIN) { E(acc, cur, wr, wc, fr, fq); S.done(cur); }
        if (!has_next) break;
#pragma unroll
        for (int a = 0; a < 2; ++a)
#pragma unroll
            for (int b = 0; b < 2; ++b)
#pragma unroll
                for (int m = 0; m < 4; ++m)
#pragma unroll
                    for (int n = 0; n < 2; ++n) acc[a][b][m][n] = (f32x4){0.f, 0.f, 0.f, 0.f};
        cur = nxt; cA = nA; cB = nB; ++ui;
        if constexpr (ALIGN_EPI) { if (wr == 1) PG8_BAR; }
    }
    PG8_WAIT_V(0);
    if constexpr (!ALIGN_EPI) { if (wr == 0) PG8_BAR; }
    PG8_BAR;
    if constexpr (Epi::AFTER_DRAIN) { E.fused(acc, cur, wr, wc, fr, fq, lds, wid, lane); S.done(cur); }
#undef PG8_SA
#undef PG8_SB
#undef PG8_STAGE
#undef PG8_LDA
#undef PG8_LDB
#undef PG8_MMA
#undef PG8_WAIT_V
#undef PG8_WAIT_L
#undef PG8_BAR
#undef PG8_SCHED
}
}

#ifndef PG8_SP2
#define PG8_SP2 true
#endif
#ifndef PG8_ALIGN
#define PG8_ALIGN true
#endif
#ifndef PROBE_P2
#define PROBE_P2 1
#endif
#ifndef PROBE_P3D
#define PROBE_P3D 0
#endif
#ifndef PROBE_P4D
#define PROBE_P4D 0
#endif
#ifndef PROBE_P5
#define PROBE_P5 1
#endif
#ifndef SCOUT
#define SCOUT 3
#endif
#ifndef PROBE_P8
#define PROBE_P8 1
#endif
#ifndef PROBE_P1
#define PROBE_P1 1
#endif
#ifndef PROBE_RED
#define PROBE_RED 0
#endif
#ifndef PROBE_SYNC
#define PROBE_SYNC 0
#endif
#ifndef MK_MULTI
#define MK_MULTI 0
#endif

constexpr int DM = 2048, SEQ = 16384, MLAT = 32768, MCTX = 512, MR = 33280;
constexpr int NPROJ = 14592;
constexpr int NPHASE = 10;
typedef unsigned short bf16_t;
typedef short bf16x8 __attribute__((ext_vector_type(8)));
typedef float f32x4 __attribute__((ext_vector_type(4)));
typedef float f32x16 __attribute__((ext_vector_type(16)));
typedef unsigned u32x4 __attribute__((ext_vector_type(4)));
typedef unsigned u32x2 __attribute__((ext_vector_type(2)));
typedef float f32x2 __attribute__((ext_vector_type(2)));

constexpr size_t SZ1 = (size_t)MR * 1024 * 2, SZ2 = (size_t)MR * 2048 * 2;
constexpr size_t WS_MOD = 0;
constexpr size_t WS_XBAR = 131072;
constexpr size_t WS_AQ = 1u << 20;
constexpr size_t WS_AK = WS_AQ + SZ1;
constexpr size_t WS_AVT = WS_AK + SZ1;
constexpr size_t WS_AZ = WS_AVT + SZ1;
constexpr size_t WS_BQ = WS_AZ + SZ1;
constexpr size_t WS_BK = WS_BQ + SZ1;
constexpr size_t WS_BVT = WS_BK + SZ1;
constexpr size_t WS_BZ = WS_BVT + SZ2;
constexpr size_t WS_MGA = WS_BZ + SZ2;
constexpr size_t WS_MGB = WS_MGA + SZ2;
constexpr size_t WS_BG = WS_MGB + SZ2;
constexpr size_t WS_WA = WS_BG + (size_t)MR * 32 * 4;
constexpr size_t WS_WB = WS_WA + (size_t)2048 * 1024 * 2;
constexpr size_t WS_WO = WS_WB + (size_t)2048 * 2048 * 2;
constexpr size_t WS_ATT = WS_WO + (size_t)2048 * 2048 * 2;
constexpr size_t WS_DL = WS_ATT + (size_t)2 * MLAT * 256 * 2;
constexpr size_t WS_END = WS_DL + (size_t)2 * 520 * 1024 * 4;
static_assert(WS_END <= (size_t)1073741824, "workspace map exceeds 1 GiB");
constexpr size_t DO_H = 0, DO_WIN = SZ2, DO_OF = 0, DO_OB = (size_t)MLAT * 2048 * 2;
static_assert(DO_WIN + (size_t)NPROJ * 2048 * 2 <= (size_t)MLAT * 2048 * 4, "d_out scratch");

constexpr int LDS_BYTES = 147456;

struct Args {
    const float *x, *c, *ctx, *c_ctx, *w_mod, *b_mod, *w_in, *na_rpb, *w_gate2, *b_gate, *norm_g, *w_br_a, *w_br_b, *w_out, *ln_g, *ln_b;
    float* out; unsigned char* ws; int ph_lo, ph_hi;
};

typedef __bf16 bf16x2_t __attribute__((ext_vector_type(2)));
__device__ __forceinline__ unsigned pk2(float lo, float hi) { const f32x2 v = {lo, hi}; const bf16x2_t b = __builtin_convertvector(v, bf16x2_t); return __builtin_bit_cast(unsigned, b); }
__device__ __forceinline__ float bflo(unsigned u) { return __builtin_bit_cast(float, u << 16); }
__device__ __forceinline__ float bfhi(unsigned u) { return __builtin_bit_cast(float, u & 0xffff0000u); }
__device__ __forceinline__ float silu_f(float v) { return v * __builtin_amdgcn_rcpf(1.f + __expf(-v)); }
__device__ __forceinline__ float sigmoid_f(float v) { return __builtin_amdgcn_rcpf(1.f + __expf(-v)); }
__device__ __forceinline__ float wave_sum(float v) {
#pragma unroll
    for (int o = 1; o < 64; o <<= 1) v += __shfl_xor(v, o);
    return v;
}
__device__ __forceinline__ f32x4 mfma16(bf16x8 a, bf16x8 b, f32x4 c) { return __builtin_amdgcn_mfma_f32_16x16x32_bf16(a, b, c, 0, 0, 0); }
__device__ __forceinline__ f32x16 mfma32(bf16x8 a, bf16x8 b, f32x16 c) { return __builtin_amdgcn_mfma_f32_32x32x16_bf16(a, b, c, 0, 0, 0); }

__device__ __forceinline__ void transpose_item(const float* W, int ldw, int K, bf16_t* WT, int k0, int n0, int drow0, float* scr, int lane) {
#pragma unroll 8
    for (int i = 0; i < 32; ++i) { const int kk = 2 * i + (lane >> 5); scr[kk * 33 + (lane & 31)] = W[(size_t)(k0 + kk) * ldw + n0 + (lane & 31)]; }
    asm volatile("s_waitcnt lgkmcnt(0)" ::: "memory");
    const int c = lane & 7;
#pragma unroll
    for (int j = 0; j < 4; ++j) { const int n = (lane >> 3) + 8 * j; const float* s = scr + (8 * c) * 33 + n;
        u32x4 o; o.x = pk2(s[0 * 33], s[1 * 33]); o.y = pk2(s[2 * 33], s[3 * 33]); o.z = pk2(s[4 * 33], s[5 * 33]); o.w = pk2(s[6 * 33], s[7 * 33]);
        *(u32x4*)(WT + (size_t)(drow0 + n) * K + k0 + 8 * c) = o; }
    asm volatile("s_waitcnt lgkmcnt(0)" ::: "memory");
}

__device__ __forceinline__ void phase0(const Args& a, unsigned char* smem, int tid, int lane, int wave) {
    const int gw = blockIdx.x * 8 + wave, NGW = gridDim.x * 8;
    float* sv = (float*)(smem + 69632);
    for (int i = tid; i < 3 * 2048; i += 512) { const int j = i >> 11, k = i & 2047; const float v = (j < 2) ? a.c[j * 2048 + k] : a.c_ctx[k]; sv[i] = silu_f(v); }
    __syncthreads();
    float* MOD = (float*)(a.ws + WS_MOD);
    for (int it = gw; it < 1536; it += NGW) {
        const int ks = it / 24, cb = it % 24, k0 = ks * 32;
        const float* wp = a.w_mod + (size_t)k0 * 6144 + cb * 256 + lane * 4;
        f32x4 a0 = {0.f, 0.f, 0.f, 0.f}, a1 = a0, a2 = a0;
#pragma unroll 8
        for (int kk = 0; kk < 32; ++kk) { const f32x4 w = *(const f32x4*)(wp + (size_t)kk * 6144);
            a0 += w * sv[k0 + kk]; a1 += w * sv[2048 + k0 + kk]; a2 += w * sv[4096 + k0 + kk]; }
        float* mo = MOD + cb * 256 + lane * 4;
#pragma unroll
        for (int e = 0; e < 4; ++e) { __hip_atomic_fetch_add(mo + e, a0[e], __ATOMIC_RELAXED, __HIP_MEMORY_SCOPE_AGENT);
            __hip_atomic_fetch_add(mo + 6144 + e, a1[e], __ATOMIC_RELAXED, __HIP_MEMORY_SCOPE_AGENT);
            __hip_atomic_fetch_add(mo + 12288 + e, a2[e], __ATOMIC_RELAXED, __HIP_MEMORY_SCOPE_AGENT); }
    }
    float* scr = (float*)(smem + wave * 8448);
    bf16_t* WinT = (bf16_t*)((unsigned char*)a.out + DO_WIN);
    constexpr int I_IN = 32 * 449, I_A = 16 * 64, I_B = 32 * 64, I_O = 32 * 64;
    for (int it = gw; it < I_IN + I_A + I_B + I_O; it += NGW) {
        int r = it;
        if (r < I_IN) { const int kb = r / 449, nb = r % 449, n0 = nb * 32;
            const int drow = n0 < 10240 ? n0 : (n0 < 10272 ? 14336 + (n0 - 10240) : n0 - 32);
            transpose_item(a.w_in, 14368, 2048, WinT, kb * 64, n0, drow, scr, lane); continue; }
        r -= I_IN;
        if (r < I_A) { transpose_item(a.w_br_a, 2048, 1024, (bf16_t*)(a.ws + WS_WA), (r >> 6) * 64, (r & 63) * 32, (r & 63) * 32, scr, lane); continue; }
        r -= I_A;
        if (r < I_B) { transpose_item(a.w_br_b, 2048, 2048, (bf16_t*)(a.ws + WS_WB), (r >> 6) * 64, (r & 63) * 32, (r & 63) * 32, scr, lane); continue; }
        r -= I_B;
        transpose_item(a.w_out, 2048, 2048, (bf16_t*)(a.ws + WS_WO), (r >> 6) * 64, (r & 63) * 32, (r & 63) * 32, scr, lane);
    }
    { u32x4* z = (u32x4*)(WinT + (size_t)14368 * 2048); const u32x4 zero = {0u, 0u, 0u, 0u};
      for (int i = blockIdx.x * 512 + tid; i < 224 * 256; i += gridDim.x * 512) z[i] = zero; }
}

__device__ __forceinline__ void phase1(const Args& a, unsigned char* smem, int tid, int lane, int wave) {
    const int gw = blockIdx.x * 8 + wave, NGW = gridDim.x * 8;
    float* ss = (float*)smem;
    const float* MOD = (const float*)(a.ws + WS_MOD);
    for (int i = tid; i < 3 * 2048; i += 512) { const int j = i >> 11, k = i & 2047;
        ss[(j * 2 + 0) * 2048 + k] = 1.f + MOD[j * 6144 + 2048 + k] + a.b_mod[2048 + k];
        ss[(j * 2 + 1) * 2048 + k] = MOD[j * 6144 + k] + a.b_mod[k]; }
    __syncthreads();
    bf16_t* H = (bf16_t*)((unsigned char*)a.out + DO_H);
    for (int r = gw; r < MR; r += NGW) {
        const float* src = r < MLAT ? a.x + (size_t)r * 2048 : a.ctx + (size_t)(r - MLAT) * 2048;
        const int j = r < MLAT ? (r >> 14) : 2;
        const f32x4* xr = (const f32x4*)src + lane;
        f32x4 v[8]; float s = 0.f;
#pragma unroll
        for (int q = 0; q < 8; ++q) { v[q] = __builtin_nontemporal_load(xr + 64 * q); s += (v[q].x + v[q].y) + (v[q].z + v[q].w); }
        const float mean = wave_sum(s) * (1.f / 2048.f); float s2 = 0.f;
#pragma unroll
        for (int q = 0; q < 8; ++q) { v[q] = v[q] - mean; s2 += (v[q].x * v[q].x + v[q].y * v[q].y) + (v[q].z * v[q].z + v[q].w * v[q].w); }
        const float rstd = rsqrtf(wave_sum(s2) * (1.f / 2048.f) + 1e-6f);
        u32x2* o8 = (u32x2*)(H + (size_t)r * 2048) + lane;
        const f32x4* sc = (const f32x4*)(ss + (j * 2 + 0) * 2048) + lane; const f32x4* sh = (const f32x4*)(ss + (j * 2 + 1) * 2048) + lane;
#pragma unroll
        for (int q = 0; q < 8; ++q) { const f32x4 y = v[q] * rstd * sc[64 * q] + sh[64 * q]; u32x2 o; o.x = pk2(y.x, y.y); o.y = pk2(y.z, y.w); o8[64 * q] = o; }
    }
}

struct EpiProj {
    static constexpr bool PERM = true, AFTER_DRAIN = false;
    unsigned char* ws; unsigned char* lds_epi;
    __device__ __forceinline__ void operator()(const f32x4 (&acc)[2][2][4][2], const pg8::Unit& u, int wr, int wc, int fr, int fq) const {
        const int pn = u.pn, row0 = u.pm * 256 + wr * 64 + fr;
        if (pn == 56) {
            if (wc == 0) { float* BG = (float*)(ws + WS_BG);
#pragma unroll
                for (int ai = 0; ai < 2; ++ai)
#pragma unroll
                    for (int m = 0; m < 4; ++m) { float* p = BG + (size_t)(row0 + ai * 128 + m * 16) * 32 + 8 * fq;
                        *(f32x4*)p = acc[ai][0][m][0]; *(f32x4*)(p + 4) = acc[ai][0][m][1]; } }
            return;
        }
        const bool tr = (pn >= 8 && pn < 12) || (pn >= 24 && pn < 32);
        unsigned char* base; int colt, ld;
        if (pn < 24) { base = ws + WS_AQ + (size_t)(pn >> 2) * SZ1; colt = (pn & 3) * 256; ld = 1024; }
        else { base = ws + WS_BVT + (size_t)((pn - 24) >> 3) * SZ2; colt = ((pn - 24) & 7) * 256; ld = 2048; }
        if (tr) {
            bf16_t* VO = (bf16_t*)base; const bool isb = pn >= 24;
            bf16_t* T = (bf16_t*)(lds_epi + (wr * 4 + wc) * 2048);
            const int lane = fq * 16 + fr, col = lane & 31, half = lane >> 5;
#pragma unroll
            for (int ai = 0; ai < 2; ++ai)
#pragma unroll
                for (int m = 0; m < 4; ++m)
#pragma unroll
                    for (int bj = 0; bj < 2; ++bj) {
#pragma unroll
                        for (int n = 0; n < 2; ++n) { const f32x4 v = acc[ai][bj][m][n]; const unsigned w0 = pk2(v[0], v[1]), w1 = pk2(v[2], v[3]);
                            bf16_t* p = T + (8 * fq + 4 * n) * 24 + fr;
                            p[0] = (bf16_t)(w0 & 0xffffu); p[24] = (bf16_t)(w0 >> 16); p[48] = (bf16_t)(w1 & 0xffffu); p[72] = (bf16_t)(w1 >> 16); }
                        asm volatile("s_waitcnt lgkmcnt(0)" ::: "memory");
                        const u32x4 w = *(const u32x4*)(T + col * 24 + half * 8);
                        asm volatile("s_waitcnt lgkmcnt(0)" ::: "memory");
                        const int dvg = colt + bj * 128 + wc * 32 + col;
                        if (isb) { const size_t gc = (size_t)u.pm * 4 + ai * 2 + wr;
                            *(u32x4*)(VO + ((((gc * 4 + (dvg >> 9)) * 16 + ((dvg >> 5) & 15)) * 4 + m) * 64 + half * 32 + col) * 8) = w; }
                        else *(u32x4*)(VO + (size_t)dvg * MR + (size_t)(u.pm * 256 + ai * 128 + wr * 64 + m * 16 + half * 8)) = w;
                    }
        } else {
            bf16_t* O = (bf16_t*)base; const int col0 = colt + wc * 32 + 8 * fq;
#pragma unroll
            for (int ai = 0; ai < 2; ++ai)
#pragma unroll
                for (int m = 0; m < 4; ++m) { bf16_t* rowp = O + (size_t)(row0 + ai * 128 + m * 16) * ld + col0;
#pragma unroll
                    for (int bj = 0; bj < 2; ++bj) { const f32x4 v0 = acc[ai][bj][m][0], v1 = acc[ai][bj][m][1];
                        u32x4 w; w.x = pk2(v0[0], v0[1]); w.y = pk2(v0[2], v0[3]); w.z = pk2(v1[0], v1[1]); w.w = pk2(v1[2], v1[3]);
                        *(u32x4*)(rowp + bj * 128) = w; } }
        }
    }
};

struct EpiMerge1 {
    static constexpr bool PERM = true, AFTER_DRAIN = false;
    bf16_t* G;
    __device__ __forceinline__ void operator()(const f32x4 (&acc)[2][2][4][2], const pg8::Unit& u, int wr, int wc, int fr, int fq) const {
        const int row0 = u.pm * 256 + wr * 64 + fr, col0 = u.pn * 256 + wc * 32 + 8 * fq;
#pragma unroll
        for (int ai = 0; ai < 2; ++ai) {
            u32x4 gb[4][2];
#pragma unroll
            for (int m = 0; m < 4; ++m)
#pragma unroll
                for (int bj = 0; bj < 2; ++bj) gb[m][bj] = *(const u32x4*)(G + (size_t)(row0 + ai * 128 + m * 16) * 2048 + col0 + bj * 128);
            asm volatile("" ::: "memory");
#pragma unroll
            for (int m = 0; m < 4; ++m) { bf16_t* rowp = G + (size_t)(row0 + ai * 128 + m * 16) * 2048 + col0;
#pragma unroll
                for (int bj = 0; bj < 2; ++bj) { const u32x4 g = gb[m][bj]; const f32x4 v0 = acc[ai][bj][m][0], v1 = acc[ai][bj][m][1];
                    u32x4 w; w.x = pk2(sigmoid_f(bflo(g.x)) * v0[0], sigmoid_f(bfhi(g.x)) * v0[1]); w.y = pk2(sigmoid_f(bflo(g.y)) * v0[2], sigmoid_f(bfhi(g.y)) * v0[3]);
                    w.z = pk2(sigmoid_f(bflo(g.z)) * v1[0], sigmoid_f(bfhi(g.z)) * v1[1]); w.w = pk2(sigmoid_f(bflo(g.w)) * v1[2], sigmoid_f(bfhi(g.w)) * v1[3]);
                    *(u32x4*)(rowp + bj * 128) = w; } }
        }
    }
};
struct EpiMerge2 {
    static constexpr bool PERM = true, AFTER_DRAIN = false;
    const bf16_t* T; const bf16_t* G; bf16_t* O;
    __device__ __forceinline__ void operator()(const f32x4 (&acc)[2][2][4][2], const pg8::Unit& u, int wr, int wc, int fr, int fq) const {
        const int row0 = u.pm * 256 + wr * 64 + fr, col0 = u.pn * 256 + wc * 32 + 8 * fq;
#pragma unroll
        for (int ai = 0; ai < 2; ++ai)
#pragma unroll
          for (int mp = 0; mp < 2; ++mp) {
            u32x4 gb[2][2], tb[2][2];
#pragma unroll
            for (int mm = 0; mm < 2; ++mm)
#pragma unroll
                for (int bj = 0; bj < 2; ++bj) { const size_t ro = (size_t)(row0 + ai * 128 + (mp * 2 + mm) * 16) * 2048 + col0 + bj * 128; gb[mm][bj] = *(const u32x4*)(G + ro); tb[mm][bj] = *(const u32x4*)(T + ro); }
            asm volatile("" ::: "memory");
#pragma unroll
            for (int mm = 0; mm < 2; ++mm) { const int m = mp * 2 + mm; const size_t ro = (size_t)(row0 + ai * 128 + m * 16) * 2048 + col0;
#pragma unroll
                for (int bj = 0; bj < 2; ++bj) { const u32x4 g = gb[mm][bj]; const u32x4 t = tb[mm][bj];
                    const f32x4 v0 = acc[ai][bj][m][0], v1 = acc[ai][bj][m][1];
                    u32x4 w; w.x = pk2(bflo(t.x) + sigmoid_f(bflo(g.x)) * v0[0], bfhi(t.x) + sigmoid_f(bfhi(g.x)) * v0[1]);
                    w.y = pk2(bflo(t.y) + sigmoid_f(bflo(g.y)) * v0[2], bfhi(t.y) + sigmoid_f(bfhi(g.y)) * v0[3]);
                    w.z = pk2(bflo(t.z) + sigmoid_f(bflo(g.z)) * v1[0], bfhi(t.z) + sigmoid_f(bfhi(g.z)) * v1[1]);
                    w.w = pk2(bflo(t.w) + sigmoid_f(bflo(g.w)) * v1[2], bfhi(t.w) + sigmoid_f(bfhi(g.w)) * v1[3]);
                    *(u32x4*)(O + ro + bj * 128) = w; } }
          }
    }
};
struct EpiOut {
    static constexpr bool PERM = true, AFTER_DRAIN = false;
    const float* x; const float* MOD; const float* b_mod; float* out;
    __device__ __forceinline__ void operator()(const f32x4 (&acc)[2][2][4][2], const pg8::Unit& u, int wr, int wc, int fr, int fq) const {
        const int row0 = u.pm * 256 + wr * 64 + fr, col0 = u.pn * 256 + wc * 32 + 8 * fq;
        const int b = (u.pm * 256) >> 14;
        f32x4 gt[2][2];
#pragma unroll
        for (int bj = 0; bj < 2; ++bj)
#pragma unroll
            for (int n = 0; n < 2; ++n) gt[bj][n] = *(const f32x4*)(MOD + b * 6144 + 4096 + col0 + bj * 128 + 4 * n) + *(const f32x4*)(b_mod + 4096 + col0 + bj * 128 + 4 * n);
#pragma unroll
        for (int ai = 0; ai < 2; ++ai)
#pragma unroll
          for (int mp = 0; mp < 2; ++mp) {
            f32x4 xb[2][2][2];
#pragma unroll
            for (int mm = 0; mm < 2; ++mm)
#pragma unroll
                for (int bj = 0; bj < 2; ++bj)
#pragma unroll
                    for (int n = 0; n < 2; ++n) xb[mm][bj][n] = *(const f32x4*)(x + (size_t)(row0 + ai * 128 + (mp * 2 + mm) * 16) * 2048 + col0 + bj * 128 + 4 * n);
            asm volatile("" ::: "memory");
#pragma unroll
            for (int mm = 0; mm < 2; ++mm) { const int m = mp * 2 + mm; const size_t ro = (size_t)(row0 + ai * 128 + m * 16) * 2048 + col0;
#pragma unroll
                for (int bj = 0; bj < 2; ++bj)
#pragma unroll
                    for (int n = 0; n < 2; ++n)
                        *(f32x4*)(out + ro + bj * 128 + 4 * n) = xb[mm][bj][n] * 1.189207115002721f + gt[bj][n] * acc[ai][bj][m][n]; }
          }
    }
};

__device__ __forceinline__ void phase_attn(const Args& a, unsigned char* smem, int tid, int lane, int wave, bf16_t* Yout) {
    bf16_t* Ks = (bf16_t*)smem;
    bf16_t* Vs = (bf16_t*)(smem + 36864);
    float* rpb_s = (float*)(smem + 70656);
    const bf16_t* AQ = (const bf16_t*)(a.ws + WS_AQ); const bf16_t* AK = (const bf16_t*)(a.ws + WS_AK);
    const bf16_t* AVT = (const bf16_t*)(a.ws + WS_AVT); const bf16_t* AZ = (const bf16_t*)(a.ws + WS_AZ);
    const int q16 = lane & 15, g = lane >> 4, wo = 8 * (q16 >> 2) + (q16 & 3);
    for (int bu = blockIdx.x; bu < 256; bu += gridDim.x) {
        const int combo = bu >> 3, b = combo >> 4, h = combo & 15, rbase = (bu & 7) * 32;
        __syncthreads();
#pragma unroll
        for (int j = 0; j < 4; ++j) { const int c = tid + 512 * j;
            { const int key = c >> 3, ch = c & 7; *(u32x4*)(Ks + key * 72 + ch * 8) = *(const u32x4*)(AK + (size_t)(MLAT + b * 256 + key) * 1024 + h * 64 + ch * 8); }
            { const int d = c >> 5, ch = c & 31; *(u32x4*)(Vs + d * 264 + ch * 8) = *(const u32x4*)(AVT + (size_t)(h * 64 + d) * MR + MLAT + b * 256 + ch * 8); } }
        if (tid < 465) rpb_s[tid] = a.na_rpb[h * 465 + tid];
        __syncthreads();
        for (int u = wave; u < 128; u += 8) {
            const int r = rbase + (u >> 2), qt = u & 3;
            const int c0 = qt * 16, kc0 = min(max(c0 - 8, 0), 32), rs = min(max(r - 4, 0), 248);
            const int qc = c0 + q16, cs = min(max(qc - 8, 0), 48);
            const size_t qrow = (size_t)b * 16384 + r * 64 + qc;
            const bf16x8 qf0 = *(const bf16x8*)(AQ + qrow * 1024 + h * 64 + 8 * g), qf1 = *(const bf16x8*)(AQ + qrow * 1024 + h * 64 + 32 + 8 * g);
            f32x4 st[32];
            bf16x8 kbuf[1][8];
#define ATT_KLOAD(bt, dstb) do { _Pragma("unroll") for (int ii_ = 0; ii_ < 2; ++ii_) _Pragma("unroll") for (int hf_ = 0; hf_ < 2; ++hf_) { \
                const size_t krow_ = (size_t)b * 16384 + (rs + (bt) * 2 + ii_) * 64 + kc0 + wo + 4 * hf_; \
                const bf16_t* kp_ = AK + krow_ * 1024 + h * 64 + 8 * g; \
                kbuf[dstb][(ii_ * 2 + hf_) * 2] = *(const bf16x8*)kp_; kbuf[dstb][(ii_ * 2 + hf_) * 2 + 1] = *(const bf16x8*)(kp_ + 32); } } while (0)
#pragma unroll
            for (int bt = 0; bt < 4; ++bt) {
                ATT_KLOAD(bt, 0);
                asm volatile("" ::: "memory");
#pragma unroll
                for (int ii = 0; ii < 2; ++ii) {
                    const int i = bt * 2 + ii;
                    const float* rp = rpb_s + (rs + i - r + 7) * 31;
#pragma unroll
                    for (int hf = 0; hf < 2; ++hf) {
                        f32x4 s = {0.f, 0.f, 0.f, 0.f};
                        s = mfma16(kbuf[0][(ii * 2 + hf) * 2], qf0, s); s = mfma16(kbuf[0][(ii * 2 + hf) * 2 + 1], qf1, s);
#pragma unroll
                        for (int e = 0; e < 4; ++e) { const int kc = kc0 + 8 * g + 4 * hf + e; const bool ok = (kc >= cs) && (kc < cs + 16);
                            const int dc = min(max(kc - qc + 15, 0), 30);
                            s[e] = ok ? s[e] * 0.125f + rp[dc] : -1e30f; }
                        st[i * 2 + hf] = s;
                    }
                }
            }
#undef ATT_KLOAD
            bf16x8 vbuf[1][8];
#define ATT_VLOAD(bt, dstb) do { _Pragma("unroll") for (int pp_ = 0; pp_ < 2; ++pp_) { \
                const size_t tokb_ = (size_t)b * 16384 + (rs + (bt) * 2 + pp_) * 64 + kc0 + 8 * g; \
                _Pragma("unroll") for (int mt_ = 0; mt_ < 4; ++mt_) vbuf[dstb][pp_ * 4 + mt_] = *(const bf16x8*)(AVT + (size_t)(h * 64 + mt_ * 16 + q16) * MR + tokb_); } } while (0)
#pragma unroll
            for (int c = 0; c < 8; ++c)
#pragma unroll
                for (int hf = 0; hf < 2; ++hf) {
                    const bf16_t* kp = Ks + (c * 32 + wo + 4 * hf) * 72 + 8 * g;
                    const bf16x8 k0 = *(const bf16x8*)kp, k1 = *(const bf16x8*)(kp + 32);
                    f32x4 s = {0.f, 0.f, 0.f, 0.f};
                    s = mfma16(k0, qf0, s); s = mfma16(k1, qf1, s);
                    st[16 + c * 2 + hf] = s * 0.125f;
                }
            float mx = -1e30f;
#pragma unroll
            for (int t = 0; t < 32; ++t) mx = fmaxf(fmaxf(fmaxf(st[t][0], st[t][1]), fmaxf(st[t][2], st[t][3])), mx);
            mx = fmaxf(mx, __shfl_xor(mx, 16)); mx = fmaxf(mx, __shfl_xor(mx, 32));
            float l = 0.f;
#pragma unroll
            for (int t = 0; t < 32; ++t) {
#pragma unroll
                for (int e = 0; e < 4; ++e) { const float p = __expf(st[t][e] - mx); st[t][e] = p; l += p; } }
            l += __shfl_xor(l, 16); l += __shfl_xor(l, 32);
            bf16x8 pb[16];
#pragma unroll
            for (int p = 0; p < 16; ++p) { u32x4 pw; pw.x = pk2(st[2 * p][0], st[2 * p][1]); pw.y = pk2(st[2 * p][2], st[2 * p][3]); pw.z = pk2(st[2 * p + 1][0], st[2 * p + 1][1]); pw.w = pk2(st[2 * p + 1][2], st[2 * p + 1][3]);
                pb[p] = __builtin_bit_cast(bf16x8, pw); }
            f32x4 o[4];
#pragma unroll
            for (int mt = 0; mt < 4; ++mt) o[mt] = (f32x4){0.f, 0.f, 0.f, 0.f};
            bf16x8 vb2[1][16];
#define ATT_VLOAD16(bt, dstb) do { _Pragma("unroll") for (int pp_ = 0; pp_ < 4; ++pp_) { \
                const size_t tokb_ = (size_t)b * 16384 + (rs + (bt) * 4 + pp_) * 64 + kc0 + 8 * g; \
                _Pragma("unroll") for (int mt_ = 0; mt_ < 4; ++mt_) vb2[dstb][pp_ * 4 + mt_] = *(const bf16x8*)(AVT + (size_t)(h * 64 + mt_ * 16 + q16) * MR + tokb_); } } while (0)
            ATT_VLOAD16(0, 0);
            asm volatile("" ::: "memory");
#pragma unroll
            for (int p = 8; p < 16; ++p) {
#pragma unroll
                for (int mt = 0; mt < 4; ++mt) o[mt] = mfma16(*(const bf16x8*)(Vs + (mt * 16 + q16) * 264 + (p - 8) * 32 + 8 * g), pb[p], o[mt]);
            }
            asm volatile("" ::: "memory");
#pragma unroll
            for (int bt = 0; bt < 2; ++bt) {
                if (bt == 1) { ATT_VLOAD16(1, 0); asm volatile("" ::: "memory"); }
#pragma unroll
                for (int pp = 0; pp < 4; ++pp)
#pragma unroll
                    for (int mt = 0; mt < 4; ++mt) o[mt] = mfma16(vb2[0][pp * 4 + mt], pb[bt * 4 + pp], o[mt]);
            }
#undef ATT_VLOAD16
#undef ATT_VLOAD
            const float inv = 1.f / l;
#pragma unroll
            for (int mt = 0; mt < 4; ++mt) {
                const size_t off = qrow * 1024 + h * 64 + mt * 16 + 4 * g;
                const u32x2 z = *(const u32x2*)(AZ + off);
                u32x2 w; w.x = pk2(o[mt][0] * inv * silu_f(bflo(z.x)), o[mt][1] * inv * silu_f(bfhi(z.x)));
                w.y = pk2(o[mt][2] * inv * silu_f(bflo(z.y)), o[mt][3] * inv * silu_f(bfhi(z.y)));
                *(u32x2*)(Yout + off) = w;
            }
        }
    }
}

__device__ __forceinline__ void phase_g0(const Args& a, unsigned char* smem, int tid, int lane, int wave, bf16_t* QEFdst) {
    float* lr = (float*)smem;
    float* w2s = (float*)(smem + 4096);
    float* bs = (float*)(smem + 12288);
    float* lastv = (float*)(smem + 12800);
    float* G = (float*)(smem + 16384);
    bf16_t* KDs = (bf16_t*)(smem + 16384);
    bf16_t* QEs = (bf16_t*)(smem + 49152);
    bf16_t* KEs = (bf16_t*)(smem + 82944);
    const bf16_t* BQ = (const bf16_t*)(a.ws + WS_BQ); const bf16_t* BK = (const bf16_t*)(a.ws + WS_BK);
    const float* BG = (const float*)(a.ws + WS_BG);
    bf16_t* ATT = (bf16_t*)(a.ws + WS_ATT); float* DL = (float*)(a.ws + WS_DL);
    const int q16 = lane & 15, g = lane >> 4;
    for (int u = blockIdx.x; u < 2080; u += gridDim.x) {
        const int gc = u >> 2, h = u & 3, row0 = gc * 64; const bool is_lat = gc < 512; const int n_l = gc & 255;
        float qr[2][16], kr[2][16];
#pragma unroll
        for (int it = 0; it < 2; ++it) {
            const int item = tid + 512 * it, t = item >> 4, hf = (item >> 3) & 1, p8 = item & 7, i1 = hf * 128 + p8 * 8;
            const size_t off = (size_t)(row0 + t) * 1024 + h * 256 + i1;
            const u32x4 q1 = *(const u32x4*)(BQ + off), q2 = *(const u32x4*)(BQ + off + 64), k1 = *(const u32x4*)(BK + off), k2 = *(const u32x4*)(BK + off + 64);
            const float pos = hf ? (float)t : (float)n_l;
#pragma unroll
            for (int e = 0; e < 8; ++e) {
                float cs = 1.f, sn = 0.f;
                if (is_lat) { const float ang = pos * exp2f(-(float)(p8 * 8 + e) * 0.20762050593046014f); cs = __cosf(ang); sn = __sinf(ang); }
                const unsigned uq1 = q1[e >> 1], uq2 = q2[e >> 1], uk1 = k1[e >> 1], uk2 = k2[e >> 1];
                const float a1 = (e & 1) ? bfhi(uq1) : bflo(uq1), a2 = (e & 1) ? bfhi(uq2) : bflo(uq2);
                const float b1 = (e & 1) ? bfhi(uk1) : bflo(uk1), b2 = (e & 1) ? bfhi(uk2) : bflo(uk2);
                qr[it][e] = (a1 * cs - a2 * sn) * 0.0625f; qr[it][8 + e] = (a1 * sn + a2 * cs) * 0.0625f;
                kr[it][e] = b1 * cs - b2 * sn; kr[it][8 + e] = b1 * sn + b2 * cs;
            }
        }
#pragma unroll 1
        for (int dir = 0; dir < 2; ++dir) {
            { const int idx = tid * 2, t = idx >> 4, r = idx & 15; *(f32x2*)(lr + idx) = *(const f32x2*)(BG + (size_t)(row0 + t) * 32 + dir * 16 + r); }
            { const int idx = tid * 4, r = idx >> 7, p = idx & 127; *(f32x4*)(w2s + idx) = *(const f32x4*)(a.w_gate2 + (size_t)(dir * 16 + r) * 512 + h * 128 + p); }
            if (tid < 128) bs[tid] = a.b_gate[dir * 512 + h * 128 + tid];
            __syncthreads();
            { const int p = tid & 127, tq = tid >> 7;
#pragma unroll 4
              for (int i = 0; i < 16; ++i) { const int t = tq + 4 * i; float z = bs[p];
#pragma unroll
                  for (int r = 0; r < 16; ++r) z += lr[t * 16 + r] * w2s[r * 128 + p];
                  G[t * 128 + p] = (fminf(z, 0.f) - __logf(1.f + __expf(-fabsf(z)))) * 0.0625f; } }
            __syncthreads();
            {
                const int p = tid & 127, seg = tid >> 7; float v[16]; float run = 0.f;
#pragma unroll
                for (int s = 0; s < 16; ++s) { const int sidx = seg * 16 + s, t = dir ? 63 - sidx : sidx; run += G[t * 128 + p]; v[s] = run; }
                float* segs = w2s;
                __syncthreads();
                segs[seg * 128 + p] = run;
                __syncthreads();
                float off = 0.f;
#pragma unroll
                for (int q = 0; q < 3; ++q) off += (q < seg) ? segs[q * 128 + p] : 0.f;
#pragma unroll
                for (int s = 0; s < 16; ++s) { const int sidx = seg * 16 + s, t = dir ? 63 - sidx : sidx; G[t * 128 + p] = v[s] + off; }
                if (seg == 3) lastv[p] = run + off;
            }
            __syncthreads();
            if (tid < 256) { const int p = (tid >> 7) * 64 + (tid & 63); DL[((size_t)(dir * 520 + gc) * 4 + h) * 256 + tid] = __expf(lastv[p]); }
            unsigned kdp[2][8];
#pragma unroll
            for (int it = 0; it < 2; ++it) {
                const int item = tid + 512 * it, t = item >> 4, hf = (item >> 3) & 1, p8 = item & 7, i1 = hf * 128 + p8 * 8, gcol = hf * 64 + p8 * 8;
                float qe[16], ke[16], kd[16];
#pragma unroll
                for (int e = 0; e < 8; ++e) { const float cum = G[t * 128 + gcol + e], lst = lastv[gcol + e];
                    const float eq = __expf(cum), ek = __expf(-cum), ed = __expf(lst - cum);
                    qe[e] = qr[it][e] * eq; qe[8 + e] = qr[it][8 + e] * eq; ke[e] = kr[it][e] * ek; ke[8 + e] = kr[it][8 + e] * ek; kd[e] = kr[it][e] * ed; kd[8 + e] = kr[it][8 + e] * ed; }
                u32x4 w;
                w.x = pk2(qe[0], qe[1]); w.y = pk2(qe[2], qe[3]); w.z = pk2(qe[4], qe[5]); w.w = pk2(qe[6], qe[7]); *(u32x4*)(QEs + t * 264 + i1) = w;
                w.x = pk2(qe[8], qe[9]); w.y = pk2(qe[10], qe[11]); w.z = pk2(qe[12], qe[13]); w.w = pk2(qe[14], qe[15]); *(u32x4*)(QEs + t * 264 + i1 + 64) = w;
                w.x = pk2(ke[0], ke[1]); w.y = pk2(ke[2], ke[3]); w.z = pk2(ke[4], ke[5]); w.w = pk2(ke[6], ke[7]); *(u32x4*)(KEs + t * 264 + i1) = w;
                w.x = pk2(ke[8], ke[9]); w.y = pk2(ke[10], ke[11]); w.z = pk2(ke[12], ke[13]); w.w = pk2(ke[14], ke[15]); *(u32x4*)(KEs + t * 264 + i1 + 64) = w;
#pragma unroll
                for (int e = 0; e < 8; ++e) kdp[it][e] = pk2(kd[2 * e], kd[2 * e + 1]);
            }
            __syncthreads();
#pragma unroll
            for (int it = 0; it < 2; ++it) {
                const int item = tid + 512 * it, t = item >> 4, hf = (item >> 3) & 1, p8 = item & 7, i1 = hf * 128 + p8 * 8;
                u32x4 w; w.x = kdp[it][0]; w.y = kdp[it][1]; w.z = kdp[it][2]; w.w = kdp[it][3]; *(u32x4*)(KDs + t * 256 + i1) = w;
                w.x = kdp[it][4]; w.y = kdp[it][5]; w.z = kdp[it][6]; w.w = kdp[it][7]; *(u32x4*)(KDs + t * 256 + i1 + 64) = w;
            }
            if (is_lat) {
                const int mi = wave >> 1, nb = (wave & 1) * 2;
                f32x4 c0 = {0.f, 0.f, 0.f, 0.f}, c1 = c0;
#pragma unroll
                for (int ks = 0; ks < 8; ++ks) {
                    const bf16x8 A = *(const bf16x8*)(QEs + (16 * mi + q16) * 264 + ks * 32 + 8 * g);
                    const bf16x8 B0 = *(const bf16x8*)(KEs + (16 * nb + q16) * 264 + ks * 32 + 8 * g);
                    const bf16x8 B1 = *(const bf16x8*)(KEs + (16 * (nb + 1) + q16) * 264 + ks * 32 + 8 * g);
                    c0 = mfma16(A, B0, c0); c1 = mfma16(A, B1, c1);
                }
#pragma unroll
                for (int e = 0; e < 4; ++e) { const int t = 16 * mi + 4 * g + e;
                    bf16_t* ab = ATT + ((size_t)(dir * 512 + gc) * 4 + h) * 4096 + (size_t)((t >> 5) * 4) * 512 + (t & 31) * 8;
                    { const int tp = 16 * nb + q16; const bool keep = dir ? (tp >= t) : (tp <= t);
                      ab[(tp >> 4) * 512 + ((tp >> 3) & 1) * 256 + (tp & 7)] = (bf16_t)(pk2(keep ? c0[e] : 0.f, 0.f) & 0xffffu); }
                    { const int tp = 16 * (nb + 1) + q16; const bool keep = dir ? (tp >= t) : (tp <= t);
                      ab[(tp >> 4) * 512 + ((tp >> 3) & 1) * 256 + (tp & 7)] = (bf16_t)(pk2(keep ? c1[e] : 0.f, 0.f) & 0xffffu); }
                }
            }
            __syncthreads();
            if (is_lat) {
                bf16_t* QE = dir ? (bf16_t*)(a.ws + WS_AZ) : QEFdst;
#pragma unroll
                for (int j = 0; j < 4; ++j) { const int c = tid + 512 * j, t = c >> 5, ch = c & 31, blk = ch >> 2, s = (ch >> 1) & 1, hh = ch & 1, srcA = blk * 32 + 16 * s + 4 * hh;
                    const u32x2 lo = *(const u32x2*)(QEs + t * 264 + srcA), hi = *(const u32x2*)(QEs + t * 264 + srcA + 8);
                    u32x4 w; w.x = lo.x; w.y = lo.y; w.z = hi.x; w.w = hi.y;
                    const int slot = ((blk * 2 + (t >> 5)) * 2 + s) * 2 + hh;
                    *(u32x4*)(QE + (size_t)(row0 + slot) * 1024 + h * 256 + (t & 31) * 8) = w; }
            }
            { bf16_t* KDT = (bf16_t*)(a.ws + (dir ? WS_AVT : WS_AK));
#pragma unroll
              for (int j = 0; j < 4; ++j) { const int c = tid + 512 * j, dk = c >> 3, t8 = c & 7;
                  unsigned v[8];
#pragma unroll
                  for (int e = 0; e < 8; ++e) v[e] = KDs[(t8 * 8 + e) * 256 + dk];
                  u32x4 w; w.x = v[0] | (v[1] << 16); w.y = v[2] | (v[3] << 16); w.z = v[4] | (v[5] << 16); w.w = v[6] | (v[7] << 16);
                  *(u32x4*)(KDT + ((((size_t)gc * 4 + h) * 8 + (dk >> 5)) * 4 + (t8 >> 1)) * 512 + ((t8 & 1) * 32 + (dk & 31)) * 8) = w; } }
            __syncthreads();
        }
    }
}

__device__ __forceinline__ int scan_gc(int step, int b, int dir) {
    const int mL = -(int)(step >= 4), mD = -dir;
    const int jf = step - (4 & mL), jb = ((259 & mL) | (3 & ~mL)) - step;
    return (((b * 256) & mL) | ((512 + b * 4) & ~mL)) + ((jb & mD) | (jf & ~mD));
}
__device__ __forceinline__ void phase_scan(const Args& a, unsigned char* smem, int tid, int lane, int wave) {
    unsigned* red = (unsigned*)smem;
    unsigned char* vst = smem + 65536;
    unsigned char* dst = smem + 73728;
    const int l31 = lane & 31, hh = lane >> 5, kb = wave, mtA = wave >> 2;
    for (int wu = blockIdx.x; wu < 256; wu += gridDim.x) {
        const int combo = (wu & 7) * 2 + (wu >> 7), sl = (wu >> 3) & 15;
        const int b = combo >> 3, h = (combo >> 1) & 3, dir = combo & 1;
        const bf16_t* QE = (const bf16_t*)(a.ws + (dir ? WS_AZ : WS_BQ));
        const bf16_t* KDT = (const bf16_t*)(a.ws + (dir ? WS_AVT : WS_AK));
        const bf16_t* ATT = (const bf16_t*)(a.ws + WS_ATT) + (size_t)dir * 512 * 4 * 4096;
        const float* DL = (const float*)(a.ws + WS_DL) + (size_t)dir * 520 * 1024;
        const bf16_t* BVF = (const bf16_t*)(a.ws + WS_BVT) + (size_t)lane * 8;
        bf16_t* O = (bf16_t*)((unsigned char*)a.out + (dir ? DO_OB : DO_OF));
        f32x16 S;
#pragma unroll
        for (int i = 0; i < 16; ++i) S[i] = 0.f;
        bf16x8 vB[4], qeA[4], atA; f32x4 dl[4];
        bf16x8 nqe[4], nat;
        u32x4 gcur = {0u, 0u, 0u, 0u}, gnxt = {0u, 0u, 0u, 0u};
#define SCAN_GC(step) scan_gc((step), b, dir)
#define SCAN_LOAD(step, QE_, AT_) do { const int gc_ = SCAN_GC(step); const size_t rq_ = gc_ < 512 ? (size_t)gc_ * 64 : 0; \
        _Pragma("unroll") for (int mt_ = 0; mt_ < 2; ++mt_) _Pragma("unroll") for (int s_ = 0; s_ < 2; ++s_) \
            QE_[mt_ * 2 + s_] = *(const bf16x8*)(QE + (rq_ + (((kb * 2 + (mtA ^ mt_)) * 2 + s_) * 2 + hh)) * 1024 + h * 256 + l31 * 8); \
        AT_ = *(const bf16x8*)(ATT + (((rq_ >> 6) * 4 + h) * 8 + wave) * 512 + lane * 8); } while (0)
#define SCAN_GLOAD(step, G_) do { const int gc_ = SCAN_GC(step); G_ = *(const u32x4*)(gbase + (size_t)gc_ * gstride); } while (0)
#define SCAN_GSTORE(buf, G_) do { *(u32x4*)(glds + (buf) * glstride) = G_; } while (0)
#define SCAN_LREAD(buf, VB_, DL_) do { _Pragma("unroll") for (int q_ = 0; q_ < 4; ++q_) { \
        VB_[q_] = *(const bf16x8*)(vst + (((buf) * 4 + q_) * 64 + lane) * 16); \
        DL_[q_] = *(const f32x4*)(dst + (buf) * 1024 + (kb * 32 + 8 * q_ + 4 * hh) * 4); } } while (0)
        const unsigned char* scb; unsigned scsg;
        { const int q16s = sl * 16 + (lane & 15);
          if (wave == 5) { if (lane < 16) { scb = (const unsigned char*)KDT + (size_t)h * 32768 + (size_t)q16s * 128; scsg = 131072u; }
                           else if (lane < 32) { scb = (const unsigned char*)QE + (size_t)h * 512 + (size_t)(q16s >> 2) * 2048 + (q16s & 3) * 128; scsg = 131072u; }
                           else if (lane < 36) { scb = (const unsigned char*)ATT + (size_t)h * 8192 + (size_t)(sl * 4 + lane - 32) * 128; scsg = 32768u; }
                           else { scb = (const unsigned char*)DL + (size_t)h * 1024 + (lane & 7) * 128; scsg = 4096u; } }
          else if (wave == 6) { scb = (const unsigned char*)(a.ws + WS_BVT) + (size_t)(h * 16 + sl) * 4096 + (size_t)(lane & 31) * 128; scsg = 262144u; }
          else { scb = (const unsigned char*)DL + (size_t)h * 1024; scsg = 0u; } }
        unsigned scA = 0u, scB = 0u;
        const unsigned char* gbase; unsigned gstride; unsigned char* glds; int glstride;
        if (wave < 4) { gbase = (const unsigned char*)(a.ws + WS_BVT) + ((size_t)(h * 16 + sl) * 4 + wave) * 1024 + lane * 16; gstride = 262144u; glds = vst + (wave * 64 + lane) * 16; glstride = 4096; }
        else if (wave == 4) { gbase = (const unsigned char*)DL + (size_t)h * 1024 + lane * 16; gstride = 4096u; glds = dst + lane * 16; glstride = 1024; }
        else { gbase = (const unsigned char*)DL + (size_t)h * 1024 + lane * 16; gstride = 4096u; glds = smem + 75776 + ((wave - 5) * 64 + lane) * 16; glstride = 0; }
        __syncthreads();
        SCAN_GLOAD(0, gcur); SCAN_GSTORE(0, gcur);
        SCAN_GLOAD(1, gcur);
        SCAN_LOAD(0, qeA, atA);
        __syncthreads();
        SCAN_LREAD(0, vB, dl);
        __builtin_amdgcn_s_waitcnt(0x0F70);
        auto stepf = [&](const int step, unsigned& sc_issue, unsigned& sc_consume) __attribute__((always_inline)) {
            const int nstep = step < 259 ? step + 1 : step, n2 = step < 258 ? step + 2 : 259;
            SCAN_LOAD(nstep, nqe, nat);
            SCAN_GLOAD(n2, gnxt);
#if SCOUT
            { int ss = step + SCOUT; ss = ss > 259 ? 259 : ss; const int gcs = SCAN_GC(ss); sc_issue = *(const unsigned*)(scb + (size_t)gcs * scsg); }
#endif
            const int gc = SCAN_GC(step); const size_t row0 = (size_t)gc * 64;
            bf16x8 kdA[4];
            { const bf16_t* kp = KDT + (((size_t)gc * 4 + h) * 8 + kb) * 2048 + lane * 8;
#pragma unroll
              for (int q = 0; q < 4; ++q) kdA[q] = *(const bf16x8*)(kp + 512 * q); }
            const int rbuf = step & 1, nbuf = rbuf ^ 1;
            if (gc < 512) {
                u32x4 s0, s1;
                s0.x = pk2(S[0], S[1]); s0.y = pk2(S[2], S[3]); s0.z = pk2(S[4], S[5]); s0.w = pk2(S[6], S[7]);
                s1.x = pk2(S[8], S[9]); s1.y = pk2(S[10], S[11]); s1.z = pk2(S[12], S[13]); s1.w = pk2(S[14], S[15]);
                const bf16x8 sb0 = __builtin_bit_cast(bf16x8, s0), sb1 = __builtin_bit_cast(bf16x8, s1);
                f32x16 o0, o1;
#pragma unroll
                for (int i = 0; i < 16; ++i) { o0[i] = 0.f; o1[i] = 0.f; }
                const bf16x8 vs = *(const bf16x8*)(vst + ((rbuf * 4 + (wave & 3)) * 64 + lane) * 16);
                o0 = mfma32(qeA[0], sb0, o0); o0 = mfma32(qeA[1], sb1, o0);
                o1 = mfma32(qeA[2], sb0, o1); o1 = mfma32(qeA[3], sb1, o1);
                o0 = mfma32(atA, vs, o0);
                unsigned* rb = red + (size_t)(rbuf * 8 + wave) * 1024 + lane; unsigned* rbx = red + (size_t)(rbuf * 8 + wave) * 1024 + (lane ^ 32);
#pragma unroll
                for (int i = 0; i < 8; ++i) { unsigned* w_ = (i & 1) ? rbx : rb; w_[mtA * 512 + i * 64] = pk2(o0[2 * i], o0[2 * i + 1]); w_[(mtA ^ 1) * 512 + i * 64] = pk2(o1[2 * i], o1[2 * i + 1]); }
            }
            SCAN_GSTORE(nbuf, gcur);
            __syncthreads();
            if (gc < 512) {
                const int tp = tid >> 4, dv2 = (tid & 15) * 2, t = tp * 2, mt = t >> 5, tl = t & 31, pi = 2 * (tl >> 3) + ((tl & 3) >> 1), ln = ((tl >> 2) & 1) * 32 + dv2;
                const unsigned* rp = red + (size_t)rbuf * 8192 + (mt * 8 + pi) * 64 + (ln ^ ((pi & 1) << 5));
                float a0 = 0.f, a1 = 0.f, b0 = 0.f, b1 = 0.f;
#pragma unroll
                for (int w = 0; w < 8; ++w) { const u32x2 v = *(const u32x2*)(rp + w * 1024); a0 += bflo(v.x); b0 += bfhi(v.x); a1 += bflo(v.y); b1 += bfhi(v.y); }
                bf16_t* op = O + (row0 + t) * 2048 + h * 512 + sl * 32 + dv2;
                *(unsigned*)op = pk2(a0, a1); *(unsigned*)(op + 2048) = pk2(b0, b1);
            }
            f32x4 ndl[4]; bf16x8 nvB[4];
            SCAN_LREAD(nbuf, nvB, ndl);
#pragma unroll
            for (int i = 0; i < 16; ++i) S[i] *= dl[i >> 2][i & 3];
#pragma unroll
            for (int ks = 0; ks < 4; ++ks) S = mfma32(kdA[ks], vB[ks], S);
#pragma unroll
            for (int i = 0; i < 4; ++i) { vB[i] = nvB[i]; dl[i] = ndl[i]; qeA[i] = nqe[i]; }
            atA = nat; gcur = gnxt;
#if SCOUT
            asm volatile("" :: "v"(sc_consume));
#endif
        };
#pragma unroll 1
        for (int step = 0; step < 260; step += 2) { stepf(step, scA, scB); stepf(step + 1, scB, scA); }
        asm volatile("" :: "v"(scA), "v"(scB));
        __syncthreads();
#undef SCAN_LREAD
#undef SCAN_GSTORE
#undef SCAN_GLOAD
#undef SCAN_LOAD
#undef SCAN_GC
    }
}

__device__ __forceinline__ void phase_ybz(const Args& a, int lane, int wave) {
    const bf16_t* OF = (const bf16_t*)((unsigned char*)a.out + DO_OF); const bf16_t* OB = (const bf16_t*)((unsigned char*)a.out + DO_OB);
    bf16_t* BZ = (bf16_t*)(a.ws + WS_BZ);
    const f32x4 g0 = *(const f32x4*)(a.norm_g + lane * 8), g1 = *(const f32x4*)(a.norm_g + lane * 8 + 4);
    const int NW = gridDim.x * 8;
    for (int it0 = blockIdx.x * 8 + wave; it0 < MLAT * 4; it0 += 4 * NW) {
        u32x4 f[4], bb[4], z[4]; size_t off[4];
#pragma unroll
        for (int k = 0; k < 4; ++k) { const int it = min(it0 + k * NW, MLAT * 4 - 1); off[k] = (size_t)(it >> 2) * 2048 + (it & 3) * 512 + lane * 8;
            f[k] = __builtin_nontemporal_load((const u32x4*)(OF + off[k])); bb[k] = __builtin_nontemporal_load((const u32x4*)(OB + off[k])); z[k] = __builtin_nontemporal_load((const u32x4*)(BZ + off[k])); }
#pragma unroll
        for (int k = 0; k < 4; ++k) {
            float o[8]; float ss = 0.f;
#pragma unroll
            for (int e = 0; e < 4; ++e) { o[2 * e] = bflo(f[k][e]) + bflo(bb[k][e]); o[2 * e + 1] = bfhi(f[k][e]) + bfhi(bb[k][e]); }
#pragma unroll
            for (int e = 0; e < 8; ++e) ss += o[e] * o[e];
            const float rs = rsqrtf(wave_sum(ss) * (1.f / 512.f) + 1e-6f);
            u32x4 w;
            w.x = pk2(o[0] * rs * g0[0] * silu_f(bflo(z[k].x)), o[1] * rs * g0[1] * silu_f(bfhi(z[k].x)));
            w.y = pk2(o[2] * rs * g0[2] * silu_f(bflo(z[k].y)), o[3] * rs * g0[3] * silu_f(bfhi(z[k].y)));
            w.z = pk2(o[4] * rs * g1[0] * silu_f(bflo(z[k].z)), o[5] * rs * g1[1] * silu_f(bfhi(z[k].z)));
            w.w = pk2(o[6] * rs * g1[2] * silu_f(bflo(z[k].w)), o[7] * rs * g1[3] * silu_f(bfhi(z[k].w)));
            if (it0 + k * NW < MLAT * 4) *(u32x4*)(BZ + off[k]) = w;
        }
    }
}

__device__ __forceinline__ void phase_ln(const Args& a, int lane, int wave) {
    for (int r = blockIdx.x * 8 + wave; r < MLAT; r += gridDim.x * 8) {
        f32x4* xr = (f32x4*)(a.out + (size_t)r * 2048) + lane;
        f32x4 v[8]; float s = 0.f;
#pragma unroll
        for (int q = 0; q < 8; ++q) { v[q] = __builtin_nontemporal_load(xr + 64 * q); s += (v[q].x + v[q].y) + (v[q].z + v[q].w); }
        const float mean = wave_sum(s) * (1.f / 2048.f); float s2 = 0.f;
#pragma unroll
        for (int q = 0; q < 8; ++q) { v[q] = v[q] - mean; s2 += (v[q].x * v[q].x + v[q].y * v[q].y) + (v[q].z * v[q].z + v[q].w * v[q].w); }
        const float rstd = rsqrtf(wave_sum(s2) * (1.f / 2048.f) + 1e-6f);
        const f32x4* gg = (const f32x4*)a.ln_g + lane; const f32x4* bb = (const f32x4*)a.ln_b + lane;
#pragma unroll
        for (int q = 0; q < 8; ++q) __builtin_nontemporal_store(v[q] * rstd * gg[64 * q] + bb[64 * q], xr + 64 * q);
    }
}

#define LAS __attribute__((address_space(3)))
#define XB_TMO      128
#define XB_XCNT(j)  (256  + 64 * (j))
#define XB_XSUB(j)  (1280 + 64 * (j))
#define XB_XGEN(j)  (2304 + 64 * (j))
#define XB_TOP      3328
#define XB_TOPGEN   3392
#define XCD_BAR_WORDS 3456
#define XB_SPIN_CAP (1u << 18)

__device__ __forceinline__ unsigned xb_ld(unsigned* p)              { return __hip_atomic_load(p, __ATOMIC_RELAXED, __HIP_MEMORY_SCOPE_AGENT); }
__device__ __forceinline__ unsigned xb_add(unsigned* p, unsigned v) { return __hip_atomic_fetch_add(p, v, __ATOMIC_RELAXED, __HIP_MEMORY_SCOPE_AGENT); }
__device__ __forceinline__ unsigned xb_xcc_id() { return (unsigned)__builtin_amdgcn_s_getreg((3 << 11) | 20) & 0xFu; }
#define XB_SPIN(cond, bar) do { unsigned _sp = 0; while (cond) { __builtin_amdgcn_s_sleep(1); \
    if ((++_sp & 255u) == 0u) { if (xb_ld(&(bar)[XB_TMO])) break; if (_sp > XB_SPIN_CAP) { atomicAdd(&(bar)[XB_TMO], 1u); break; } } } } while (0)

struct XcdBarrier {
    unsigned* bar; unsigned x;
    volatile LAS unsigned* st;
};

__device__ __forceinline__ XcdBarrier xcd_barrier_post(unsigned* bar, volatile LAS unsigned* st) {
    XcdBarrier b; b.bar = bar; b.x = xb_xcc_id(); b.st = st;
    if (threadIdx.x == 0) (void)xb_add(&bar[XB_XCNT(b.x)], 1u);
    return b;
}
__device__ __forceinline__ void xcd_barrier_complete(unsigned* bar, unsigned x, unsigned& nloc, unsigned& nx) {
    const unsigned G = gridDim.x * gridDim.y * gridDim.z;
    unsigned sum, cnt, mine, sp = 0u;
    for (;;) {
        sum = 0u; cnt = 0u; mine = 0u;
#pragma unroll
        for (unsigned j = 0; j < 16; ++j) { const unsigned c = xb_ld(&bar[XB_XCNT(j)]); sum += c; cnt += (c > 0u) ? 1u : 0u; mine = (j == x) ? c : mine; }
        if (sum == G) break;
        __builtin_amdgcn_s_sleep(1);
        if ((++sp & 255u) == 0u) { if (xb_ld(&bar[XB_TMO])) break; if (sp > XB_SPIN_CAP) { atomicAdd(&bar[XB_TMO], 1u); break; } }
    }
    nloc = mine > 0u ? mine : 1u; nx = cnt > 0u ? cnt : 1u;
}

__device__ __forceinline__ void xcd_barrier(const XcdBarrier& b) {
    asm volatile("s_waitcnt vmcnt(0)" ::: "memory");
    __syncthreads();
    if (threadIdx.x == 0) {
        unsigned* bar = b.bar;
        __builtin_amdgcn_s_waitcnt(0);
        unsigned nloc = b.st[0], nx = b.st[1];
        if (nloc == 0u) { xcd_barrier_complete(bar, b.x, nloc, nx); b.st[0] = nloc; b.st[1] = nx; }
        const unsigned old = xb_add(&bar[XB_XSUB(b.x)], 1u);
        const unsigned gen = old / nloc;
        if (old + 1u == (gen + 1u) * nloc) {
            __builtin_amdgcn_fence(__ATOMIC_RELEASE, "agent");
            asm volatile("s_waitcnt vmcnt(0)" ::: "memory");
            const unsigned og = xb_add(&bar[XB_TOP], 1u);
            const unsigned tg = og / nx;
            if (og + 1u == (tg + 1u) * nx) xb_add(&bar[XB_TOPGEN], 1u);
            else XB_SPIN(xb_ld(&bar[XB_TOPGEN]) == tg, bar);
            __builtin_amdgcn_fence(__ATOMIC_ACQUIRE, "agent");
            xb_add(&bar[XB_XGEN(b.x)], 1u);
            asm volatile("s_waitcnt vmcnt(0)" ::: "memory");
        } else {
            XB_SPIN(xb_ld(&bar[XB_XGEN(b.x)]) == gen, bar);
            __builtin_amdgcn_fence(__ATOMIC_ACQUIRE, "agent");
            asm volatile("s_waitcnt vmcnt(0)" ::: "memory");
        }
    }
    __syncthreads();
}

__global__ void __launch_bounds__(512, 2) mk_fwd(Args a) {
    extern __shared__ __attribute__((aligned(16))) unsigned char smem[];
    const int tid = threadIdx.x, lane = tid & 63, wave = __builtin_amdgcn_readfirstlane(tid >> 6);
    const int lo = a.ph_lo, hi = a.ph_hi;
#define IN(k) (lo <= (k) && (k) < hi)
#define SEAM(k) do { if (IN(k) && IN((k) + 1)) { xcd_barrier(xbar); } } while (0)
    PG8_LAS unsigned char* ring = (PG8_LAS unsigned char*)smem;
    volatile LAS unsigned* xst = (volatile LAS unsigned*)((LAS unsigned char*)smem + 147440);
    if (tid < 4) xst[tid] = 0u;
    __syncthreads();
    XcdBarrier xbar = xcd_barrier_post((unsigned*)(a.ws + WS_XBAR), xst);
    if (a.ph_hi > 1000) cg::this_grid().sync();
    if (IN(0)) { phase0(a, smem, tid, lane, wave); }
    SEAM(0);
    if (IN(1)) { phase1(a, smem, tid, lane, wave); if (PROBE_P1 > 1) { __syncthreads(); phase1(a, smem, tid, lane, wave); } }
    SEAM(1);
    if (IN(2)) {
        pg8::Gemm g{(const bf16_t*)((unsigned char*)a.out + DO_H), (const bf16_t*)((unsigned char*)a.out + DO_WIN), MR, NPROJ, 2048};
        pg8::StaticOrder S; S.init(MR, NPROJ, gridDim.x, (int)blockIdx.x);
        EpiProj E{a.ws, smem + 131072};
        pg8::gemm_phase<EpiProj, pg8::StaticOrder, PG8_ALIGN, PG8_SP2>(ring, g, S, E);
        if (PROBE_P2 > 1) { __syncthreads(); pg8::gemm_phase<EpiProj, pg8::StaticOrder, PG8_ALIGN, PG8_SP2>(ring, g, S, E); }
    }
    SEAM(2);
    if (IN(3)) { for (int rep = 0; rep < PROBE_P3D; ++rep) { phase_attn(a, smem, tid, lane, wave, (bf16_t*)a.out); __syncthreads(); }
                 phase_attn(a, smem, tid, lane, wave, (bf16_t*)(a.ws + WS_AQ)); }
    SEAM(3);
    if (IN(4)) { for (int rep = 0; rep < PROBE_P4D; ++rep) { phase_g0(a, smem, tid, lane, wave, (bf16_t*)a.out); __syncthreads(); }
                 phase_g0(a, smem, tid, lane, wave, (bf16_t*)(a.ws + WS_BQ)); }
    SEAM(4);
    if (IN(5)) { for (int rep = 0; rep < PROBE_P5; ++rep) { phase_scan(a, smem, tid, lane, wave); __syncthreads(); } }
    SEAM(5);
    if (IN(6)) { phase_ybz(a, lane, wave); }
    SEAM(6);
    if (IN(7)) {
        pg8::StaticOrder S; S.init(MLAT, 2048, gridDim.x, (int)blockIdx.x);
        { pg8::Gemm g{(const bf16_t*)(a.ws + WS_AQ), (const bf16_t*)(a.ws + WS_WA), MLAT, 2048, 1024};
          EpiMerge1 E{(bf16_t*)(a.ws + WS_MGA)};
          pg8::gemm_phase<EpiMerge1, pg8::StaticOrder, PG8_ALIGN, PG8_SP2>(ring, g, S, E); }
        __syncthreads();
        { pg8::Gemm g{(const bf16_t*)(a.ws + WS_BZ), (const bf16_t*)(a.ws + WS_WB), MLAT, 2048, 2048};
          EpiMerge2 E{(const bf16_t*)(a.ws + WS_MGA), (const bf16_t*)(a.ws + WS_MGB), (bf16_t*)(a.ws + WS_AK)};
          pg8::gemm_phase<EpiMerge2, pg8::StaticOrder, PG8_ALIGN, PG8_SP2>(ring, g, S, E); }
    }
    SEAM(7);
    if (IN(8)) {
        pg8::Gemm g{(const bf16_t*)(a.ws + WS_AK), (const bf16_t*)(a.ws + WS_WO), MLAT, 2048, 2048};
        pg8::StaticOrder S; S.init(MLAT, 2048, gridDim.x, (int)blockIdx.x);
        EpiOut E{a.x, (const float*)(a.ws + WS_MOD), a.b_mod, a.out};
        pg8::gemm_phase<EpiOut, pg8::StaticOrder, PG8_ALIGN, PG8_SP2>(ring, g, S, E);
        if (PROBE_P8 > 1) { __syncthreads(); pg8::gemm_phase<EpiOut, pg8::StaticOrder, PG8_ALIGN, PG8_SP2>(ring, g, S, E); }
    }
    SEAM(8);
    if (IN(9)) { for (int i = 0; i < PROBE_SYNC; ++i) xcd_barrier(xbar);
                 phase_ln(a, lane, wave); }
#undef IN
#undef SEAM
}

extern "C" void kernel_launch(void* const* d_in, const int* in_sizes, int n_in, void* d_out, int out_size, void* d_ws, size_t ws_size, hipStream_t stream) {
    static int grid = 0;
    if (grid == 0) {
        if (n_in != 16 || out_size != MLAT * 2048 || ws_size < WS_END) { fprintf(stderr, "kernel_launch: unexpected shapes (n_in %d out %d ws %zu need %zu)\n", n_in, out_size, ws_size, (size_t)WS_END); grid = -1; return; }
        int dev = 0, cus = 0, per_cu = 0;
        hipGetDevice(&dev); hipDeviceGetAttribute(&cus, hipDeviceAttributeMultiprocessorCount, dev);
        if (hipFuncSetAttribute((const void*)mk_fwd, hipFuncAttributeMaxDynamicSharedMemorySize, LDS_BYTES) != hipSuccess) { fprintf(stderr, "kernel_launch: hipFuncSetAttribute failed\n"); grid = -1; return; }
        if (hipOccupancyMaxActiveBlocksPerMultiprocessor(&per_cu, (const void*)mk_fwd, 512, LDS_BYTES) != hipSuccess || per_cu < 1) { fprintf(stderr, "kernel_launch: occupancy query says %d\n", per_cu); per_cu = 1; }
        (void)hipGetLastError();
        grid = cus * 1;
    }
    if (grid < 0) return;
    (void)hipMemsetAsync((char*)d_ws + WS_MOD, 0, 163840, stream);
    Args a{};
    a.x = (const float*)d_in[0]; a.c = (const float*)d_in[1]; a.ctx = (const float*)d_in[2]; a.c_ctx = (const float*)d_in[3];
    a.w_mod = (const float*)d_in[4]; a.b_mod = (const float*)d_in[5]; a.w_in = (const float*)d_in[6]; a.na_rpb = (const float*)d_in[7];
    a.w_gate2 = (const float*)d_in[8]; a.b_gate = (const float*)d_in[9]; a.norm_g = (const float*)d_in[10]; a.w_br_a = (const float*)d_in[11];
    a.w_br_b = (const float*)d_in[12]; a.w_out = (const float*)d_in[13]; a.ln_g = (const float*)d_in[14]; a.ln_b = (const float*)d_in[15];
    a.out = (float*)d_out; a.ws = (unsigned char*)d_ws;
#if MK_MULTI
    for (int p = 0; p < NPHASE; ++p) { a.ph_lo = p; a.ph_hi = p + 1; hipLaunchKernelGGL(mk_fwd, dim3(grid), dim3(512), LDS_BYTES, stream, a); }
#else
    a.ph_lo = 0; a.ph_hi = NPHASE;
    void* args[] = {&a};
    hipError_t e = hipLaunchCooperativeKernel((const void*)mk_fwd, dim3(grid), dim3(512), args, LDS_BYTES, stream);
    if (e != hipSuccess) fprintf(stderr, "kernel_launch: cooperative launch failed: %s (grid %d)\n", hipGetErrorString(e), grid);
#endif
}
```

```cpp
#include <hip/hip_runtime.h>
#include <hip/hip_cooperative_groups.h>
#include <cstdio>
#include <cstdint>
namespace cg = cooperative_groups;

namespace pg8 {
#define PG8_LAS __attribute__((address_space(3)))
typedef unsigned short bf16_t;
typedef short bf16x8 __attribute__((ext_vector_type(8)));
typedef float f32x4 __attribute__((ext_vector_type(4)));
typedef unsigned u32x4 __attribute__((ext_vector_type(4)));
constexpr int BM = 256, BK = 64, HALF = 128, HTB = HALF * BK * 2  , STAGE_BYTES = 8 * HTB, NXCD = 8, WGM = 8;

__host__ __device__ __forceinline__ int lds_byte(int r, int c) { const int st = (r >> 4) * 2 + (c >> 5), rr = r & 15, cc = c & 31, ob = rr * 64 + cc * 2; return st * 1024 + (ob ^ (((ob >> 9) & 1) << 5)); }
__host__ __device__ __forceinline__ void stage_rc(int b, int& R, int& C) { const int st = b / 1024, sb = b % 1024, swz = sb ^ (((sb >> 9) & 1) << 5); R = (st >> 1) * 16 + swz / 64; C = (st & 1) * 32 + (swz % 64) / 2; }
__host__ __device__ __forceinline__ int perm32(int rho) { const int n = rho >> 4, i = rho & 15; return 8 * (i >> 2) + 4 * n + (i & 3); }

struct Unit { int pm, pn; };
struct Gemm { const bf16_t* A; const bf16_t* Bt; int M, N, K; };

struct StaticOrder {
    int nM, nN, nwg, G, c;
    __host__ __device__ void init(int M, int N, int G_, int c_) { nM = M / BM; nN = N / BM; nwg = nM * nN; G = G_; c = c_; }
    __host__ __device__ bool next(int i, Unit& u) const {
        const long L = (long)i * G + c; if (L >= nwg) return false;
        int wgid = (int)L; { const int q = nwg / NXCD, r = nwg % NXCD, xcd = wgid % NXCD, off = wgid / NXCD; wgid = (xcd < r ? xcd * (q + 1) : r * (q + 1) + (xcd - r) * q) + off; }
        const int nig = WGM * nN, gid = wgid / nig, fm = gid * WGM, gsz = (nM - fm) < WGM ? (nM - fm) : WGM;
        u.pm = fm + ((wgid % nig) % gsz); u.pn = (wgid % nig) / gsz; return true;
    }
    __device__ __forceinline__ void a_ready(const Unit&) const {}
    __device__ __forceinline__ void done(const Unit&) const {}
};

__device__ __forceinline__ unsigned cvt_pk_bf16(float lo, float hi) { unsigned r; asm volatile("v_cvt_pk_bf16_f32 %0, %1, %2" : "=v"(r) : "v"(lo), "v"(hi)); return r; }

template <class Epi, class Sched, bool ALIGN_EPI = false, bool SP2 = false>
__device__ __forceinline__ void gemm_phase(PG8_LAS unsigned char* lds, const Gemm g, const Sched& S, const Epi& E) {
    const int tid = threadIdx.x, wid = __builtin_amdgcn_readfirstlane(tid >> 6), lane = tid & 63, wr = wid >> 2, wc = wid & 3, fr = lane & 15, fq = lane >> 4;
    const int K = g.K, nt = K / BK;
    unsigned voffA[2], voffB[2];
#pragma unroll
    for (int i = 0; i < 2; ++i) { int R, C; stage_rc(tid * 16 + i * 8192, R, C); const int Rb = Epi::PERM ? ((R & ~31) + perm32(R & 31)) : R;
        voffA[i] = (unsigned)(R * K + C) * 2u; voffB[i] = (unsigned)(Rb * K + C) * 2u; }
    const size_t kstep = (size_t)(BK * 2);
    const size_t hstep = (size_t)HALF * K * 2;
    const size_t tstep = 2 * hstep;
    const unsigned ldsw = (unsigned)wid * 1024u;
    const int aoff = lds_byte(wr * 64 + fr, fq * 8), boff = lds_byte(wc * 32 + fr, fq * 8);
#define PG8_SA(b, h) (((b) * 2 + (h)) * HTB)
#define PG8_SB(b, h) ((4 + (b) * 2 + (h)) * HTB)
#define PG8_STAGE(bufoff, gbase, voff) do { _Pragma("unroll") for (int _i = 0; _i < 2; ++_i) \
        __builtin_amdgcn_global_load_lds((const unsigned*)((const char*)(gbase) + (voff)[_i]), (PG8_LAS unsigned*)(lds + (bufoff) + ldsw + _i * 8192), 16, 0, 0); } while (0)
#define PG8_LDA(dst, b, h) do { _Pragma("unroll") for (int m = 0; m < 4; ++m) _Pragma("unroll") for (int k = 0; k < 2; ++k) dst[m][k] = *(const PG8_LAS bf16x8*)(lds + PG8_SA(b, h) + aoff + m * 2048 + k * 1024); } while (0)
#define PG8_LDB(dst, b, h) do { _Pragma("unroll") for (int n = 0; n < 2; ++n) _Pragma("unroll") for (int k = 0; k < 2; ++k) dst[n][k] = *(const PG8_LAS bf16x8*)(lds + PG8_SB(b, h) + boff + n * 2048 + k * 1024); } while (0)
#define PG8_MMA(ai, bj, At, Bt) do { __builtin_amdgcn_s_setprio(1); _Pragma("unroll") for (int m = 0; m < 4; ++m) _Pragma("unroll") for (int n = 0; n < 2; ++n) _Pragma("unroll") for (int k = 0; k < 2; ++k) \
        acc[ai][bj][m][n] = __builtin_amdgcn_mfma_f32_16x16x32_bf16(Bt[n][k], At[m][k], acc[ai][bj][m][n], 0, 0, 0); __builtin_amdgcn_s_setprio(0); } while (0)
#define PG8_WAIT_V(n) asm volatile("s_waitcnt vmcnt(" #n ")" ::: "memory")
#define PG8_WAIT_L(n) asm volatile("s_waitcnt lgkmcnt(" #n ")" ::: "memory")
#define PG8_BAR __builtin_amdgcn_s_barrier()
#define PG8_SCHED __builtin_amdgcn_sched_barrier(0)
    Unit cur, nxt; int ui = 0;
    if (!S.next(0, cur)) return;
    f32x4 acc[2][2][4][2];
#pragma unroll
    for (int a = 0; a < 2; ++a)
#pragma unroll
        for (int b = 0; b < 2; ++b)
#pragma unroll
            for (int m = 0; m < 4; ++m)
#pragma unroll
                for (int n = 0; n < 2; ++n) acc[a][b][m][n] = (f32x4){0.f, 0.f, 0.f, 0.f};
    bf16x8 At[4][2], B0[2][2], B1[2][2];
    const char* cA = (const char*)g.A + (size_t)cur.pm * tstep; const char* cB = (const char*)g.Bt + (size_t)cur.pn * tstep;
    S.a_ready(cur);
    if constexpr (SP2) {
        PG8_STAGE(PG8_SB(0, 0), cB, voffB); PG8_STAGE(PG8_SB(0, 1), cB + hstep, voffB); PG8_STAGE(PG8_SA(0, 0), cA, voffA); PG8_STAGE(PG8_SA(0, 1), cA + hstep, voffA);
        if (wr == 1) PG8_BAR;
        PG8_WAIT_V(2); PG8_BAR;
        PG8_STAGE(PG8_SB(1, 0), cB + kstep, voffB); PG8_STAGE(PG8_SA(1, 0), cA + kstep, voffA); PG8_STAGE(PG8_SB(1, 1), cB + hstep + kstep, voffB);
        PG8_WAIT_V(6); PG8_BAR;
    } else {
        PG8_STAGE(PG8_SB(0, 0), cB, voffB); PG8_STAGE(PG8_SA(0, 0), cA, voffA); PG8_STAGE(PG8_SB(0, 1), cB + hstep, voffB); PG8_STAGE(PG8_SA(0, 1), cA + hstep, voffA);
        if (wr == 1) PG8_BAR;
        PG8_WAIT_V(4); PG8_BAR;
        PG8_STAGE(PG8_SB(1, 0), cB + kstep, voffB); PG8_STAGE(PG8_SA(1, 0), cA + kstep, voffA); PG8_STAGE(PG8_SB(1, 1), cB + hstep + kstep, voffB);
        PG8_WAIT_V(6); PG8_BAR;
    }
    for (;;) {
        const bool has_next = S.next(ui + 1, nxt);
        const char* nA = has_next ? (const char*)g.A + (size_t)nxt.pm * tstep : cA; const char* nB = has_next ? (const char*)g.Bt + (size_t)nxt.pn * tstep : cB;
        for (int t = 0; t < nt; t += 2) {
            const bool last = (t == nt - 2);
            const char* a1 = cA + (size_t)(t + 1) * kstep;
            const char* a2 = last ? nA : cA + (size_t)(t + 2) * kstep; const char* b2 = last ? nB : cB + (size_t)(t + 2) * kstep;
            const char* a3 = a2 + kstep; const char* b3 = b2 + kstep;
            if (last && has_next) S.a_ready(nxt);
            if constexpr (SP2) {
            PG8_LDB(B0, 0, 0); PG8_LDB(B1, 0, 1); PG8_SCHED; PG8_LDA(At, 0, 0); PG8_STAGE(PG8_SA(1, 1), a1 + hstep, voffA);
            PG8_WAIT_V(8); PG8_WAIT_L(0); PG8_BAR; PG8_MMA(0, 0, At, B0); PG8_MMA(0, 1, At, B1); PG8_BAR; PG8_SCHED;
            PG8_LDA(At, 0, 1); PG8_STAGE(PG8_SB(0, 0), b2, voffB); PG8_STAGE(PG8_SB(0, 1), b2 + hstep, voffB); PG8_STAGE(PG8_SA(0, 0), a2, voffA);
            PG8_WAIT_V(8); PG8_WAIT_L(0); PG8_BAR; PG8_MMA(1, 0, At, B0); PG8_MMA(1, 1, At, B1); PG8_BAR; PG8_SCHED;
            PG8_LDB(B0, 1, 0); PG8_LDB(B1, 1, 1); PG8_SCHED; PG8_LDA(At, 1, 0); PG8_STAGE(PG8_SA(0, 1), a2 + hstep, voffA);
            PG8_WAIT_V(8); PG8_WAIT_L(0); PG8_BAR; PG8_MMA(0, 0, At, B0); PG8_MMA(0, 1, At, B1); PG8_BAR; PG8_SCHED;
            PG8_LDA(At, 1, 1); PG8_STAGE(PG8_SB(1, 0), b3, voffB); PG8_STAGE(PG8_SB(1, 1), b3 + hstep, voffB); PG8_STAGE(PG8_SA(1, 0), a3, voffA);
            PG8_WAIT_V(8); PG8_WAIT_L(0); PG8_BAR; PG8_MMA(1, 0, At, B0); PG8_MMA(1, 1, At, B1); PG8_BAR; PG8_SCHED;
            } else {
            PG8_LDB(B0, 0, 0); PG8_SCHED; PG8_LDA(At, 0, 0); PG8_STAGE(PG8_SA(1, 1), a1 + hstep, voffA);
            PG8_WAIT_L(8); PG8_BAR; PG8_WAIT_L(0); PG8_MMA(0, 0, At, B0); PG8_BAR; PG8_SCHED;
            PG8_LDB(B1, 0, 1); PG8_STAGE(PG8_SB(0, 0), b2, voffB);
            PG8_BAR; PG8_WAIT_L(0); PG8_MMA(0, 1, At, B1); PG8_BAR;
            PG8_LDA(At, 0, 1); PG8_STAGE(PG8_SA(0, 0), a2, voffA);
            PG8_BAR; PG8_WAIT_L(0); PG8_MMA(1, 0, At, B0); PG8_BAR; PG8_SCHED;
            PG8_STAGE(PG8_SB(0, 1), b2 + hstep, voffB);
            PG8_WAIT_V(6); PG8_BAR; PG8_MMA(1, 1, At, B1); PG8_BAR;
            PG8_LDB(B0, 1, 0); PG8_SCHED; PG8_LDA(At, 1, 0); PG8_STAGE(PG8_SA(0, 1), a2 + hstep, voffA);
            PG8_WAIT_L(8); PG8_BAR; PG8_WAIT_L(0); PG8_MMA(0, 0, At, B0); PG8_BAR; PG8_SCHED;
            PG8_LDB(B1, 1, 1); PG8_STAGE(PG8_SB(1, 0), b3, voffB);
            PG8_BAR; PG8_WAIT_L(0); PG8_MMA(0, 1, At, B1); PG8_BAR;
            PG8_LDA(At, 1, 1); PG8_STAGE(PG8_SA(1, 0), a3, voffA);
            PG8_BAR; PG8_WAIT_L(0); PG8_MMA(1, 0, At, B0); PG8_BAR; PG8_SCHED;
            PG8_STAGE(PG8_SB(1, 1), b3 + hstep, voffB);
            PG8_WAIT_V(6); PG8_BAR; PG8_MMA(1, 1, At, B1); PG8_BAR;
            }
        }
        if constexpr (ALIGN_EPI) { if (wr == 0) PG8_BAR; }
        if constexpr (!Epi::AFTER_DRAIN) { E(acc, cur, wr, wc, fr, fq); S.done(cur); }
        if (!has_next) break;
#pragma unroll
        for (int a = 0; a < 2; ++a)
#pragma unroll
            for (int b = 0; b < 2; ++b)
#pragma unroll
                for (int m = 0; m < 4; ++m)
#pragma unroll
                    for (int n = 0; n < 2; ++n) acc[a][b][m][n] = (f32x4){0.f, 0.f, 0.f, 0.f};
        cur = nxt; cA = nA; cB = nB; ++ui;
        if constexpr (ALIGN_EPI) { if (wr == 1) PG8_BAR; }
    }
    PG8_WAIT_V(0);
    if constexpr (!ALIGN_EPI) { if (wr == 0) PG8_BAR; }
    PG8_BAR;
    if constexpr (Epi::AFTER_DRAIN) { E.fused(acc, cur, wr, wc, fr, fq, lds, wid, lane); S.done(cur); }
#undef PG8_SA
#undef PG8_SB
#undef PG8_STAGE
#undef PG8_LDA
#undef PG8_LDB
#undef PG8_MMA
#undef PG8_WAIT_V
#undef PG8_WAIT_L
#undef PG8_BAR
#undef PG8_SCHED
}
}

#ifndef PG8_SP2
#define PG8_SP2 true
#endif
#ifndef PG8_ALIGN
#define PG8_ALIGN true
#endif
#ifndef PROBE_P2
#define PROBE_P2 1
#endif
#ifndef PROBE_P3D
#define PROBE_P3D 0
#endif
#ifndef PROBE_P4D
#define PROBE_P4D 0
#endif
#ifndef PROBE_P5
#define PROBE_P5 1
#endif
#ifndef SCOUT
#define SCOUT 3
#endif
#ifndef PROBE_P8
#define PROBE_P8 1
#endif
#ifndef PROBE_P1
#define PROBE_P1 1
#endif
#ifndef PROBE_RED
#define PROBE_RED 0
#endif
#ifndef PROBE_SYNC
#define PROBE_SYNC 0
#endif
#ifndef MK_MULTI
#define MK_MULTI 0
#endif

constexpr int DM = 2048, SEQ = 16384, MLAT = 32768, MCTX = 512, MR = 33280;
constexpr int NPROJ = 14592;
constexpr int NPHASE = 10;
typedef unsigned short bf16_t;
typedef short bf16x8 __attribute__((ext_vector_type(8)));
typedef float f32x4 __attribute__((ext_vector_type(4)));
typedef float f32x16 __attribute__((ext_vector_type(16)));
typedef unsigned u32x4 __attribute__((ext_vector_type(4)));
typedef unsigned u32x2 __attribute__((ext_vector_type(2)));
typedef float f32x2 __attribute__((ext_vector_type(2)));

constexpr size_t SZ1 = (size_t)MR * 1024 * 2, SZ2 = (size_t)MR * 2048 * 2;
constexpr size_t WS_MOD = 0;
constexpr size_t WS_XBAR = 131072;
constexpr size_t WS_AQ = 1u << 20;
constexpr size_t WS_AK = WS_AQ + SZ1;
constexpr size_t WS_AVT = WS_AK + SZ1;
constexpr size_t WS_AZ = WS_AVT + SZ1;
constexpr size_t WS_BQ = WS_AZ + SZ1;
constexpr size_t WS_BK = WS_BQ + SZ1;
constexpr size_t WS_BVT = WS_BK + SZ1;
constexpr size_t WS_BZ = WS_BVT + SZ2;
constexpr size_t WS_MGA = WS_BZ + SZ2;
constexpr size_t WS_MGB = WS_MGA + SZ2;
constexpr size_t WS_BG = WS_MGB + SZ2;
constexpr size_t WS_WA = WS_BG + (size_t)MR * 32 * 4;
constexpr size_t WS_WB = WS_WA + (size_t)2048 * 1024 * 2;
constexpr size_t WS_WO = WS_WB + (size_t)2048 * 2048 * 2;
constexpr size_t WS_ATT = WS_WO + (size_t)2048 * 2048 * 2;
constexpr size_t WS_DL = WS_ATT + (size_t)2 * MLAT * 256 * 2;
constexpr size_t WS_END = WS_DL + (size_t)2 * 520 * 1024 * 4;
static_assert(WS_END <= (size_t)1073741824, "workspace map exceeds 1 GiB");
constexpr size_t DO_H = 0, DO_WIN = SZ2, DO_OF = 0, DO_OB = (size_t)MLAT * 2048 * 2;
static_assert(DO_WIN + (size_t)NPROJ * 2048 * 2 <= (size_t)MLAT * 2048 * 4, "d_out scratch");

constexpr int LDS_BYTES = 147456;

struct Args {
    const float *x, *c, *ctx, *c_ctx, *w_mod, *b_mod, *w_in, *na_rpb, *w_gate2, *b_gate, *norm_g, *w_br_a, *w_br_b, *w_out, *ln_g, *ln_b;
    float* out; unsigned char* ws; int ph_lo, ph_hi;
};

typedef __bf16 bf16x2_t __attribute__((ext_vector_type(2)));
__device__ __forceinline__ unsigned pk2(float lo, float hi) { const f32x2 v = {lo, hi}; const bf16x2_t b = __builtin_convertvector(v, bf16x2_t); return __builtin_bit_cast(unsigned, b); }
typedef _Float16 f16x2_t __attribute__((ext_vector_type(2)));
__device__ __forceinline__ unsigned pkh2(float lo, float hi) { const f32x2 v = {lo, hi}; const f16x2_t h = __builtin_convertvector(v, f16x2_t); return __builtin_bit_cast(unsigned, h); }
__device__ __forceinline__ f32x2 unpkh2(unsigned u) { return __builtin_convertvector(__builtin_bit_cast(f16x2_t, u), f32x2); }
__device__ __forceinline__ float bflo(unsigned u) { return __builtin_bit_cast(float, u << 16); }
__device__ __forceinline__ float bfhi(unsigned u) { return __builtin_bit_cast(float, u & 0xffff0000u); }
__device__ __forceinline__ float silu_f(float v) { return v * __builtin_amdgcn_rcpf(1.f + __expf(-v)); }
__device__ __forceinline__ float sigmoid_f(float v) { return __builtin_amdgcn_rcpf(1.f + __expf(-v)); }
__device__ __forceinline__ float wave_sum(float v) {
#pragma unroll
    for (int o = 1; o < 64; o <<= 1) v += __shfl_xor(v, o);
    return v;
}
__device__ __forceinline__ f32x4 mfma16(bf16x8 a, bf16x8 b, f32x4 c) { return __builtin_amdgcn_mfma_f32_16x16x32_bf16(a, b, c, 0, 0, 0); }
__device__ __forceinline__ f32x16 mfma32(bf16x8 a, bf16x8 b, f32x16 c) { return __builtin_amdgcn_mfma_f32_32x32x16_bf16(a, b, c, 0, 0, 0); }

__device__ __forceinline__ void transpose_item(const float* W, int ldw, int K, bf16_t* WT, int k0, int n0, int drow0, float* scr, int lane) {
#pragma unroll 8
    for (int i = 0; i < 32; ++i) { const int kk = 2 * i + (lane >> 5); scr[kk * 33 + (lane & 31)] = W[(size_t)(k0 + kk) * ldw + n0 + (lane & 31)]; }
    asm volatile("s_waitcnt lgkmcnt(0)" ::: "memory");
    const int c = lane & 7;
#pragma unroll
    for (int j = 0; j < 4; ++j) { const int n = (lane >> 3) + 8 * j; const float* s = scr + (8 * c) * 33 + n;
        u32x4 o; o.x = pk2(s[0 * 33], s[1 * 33]); o.y = pk2(s[2 * 33], s[3 * 33]); o.z = pk2(s[4 * 33], s[5 * 33]); o.w = pk2(s[6 * 33], s[7 * 33]);
        *(u32x4*)(WT + (size_t)(drow0 + n) * K + k0 + 8 * c) = o; }
    asm volatile("s_waitcnt lgkmcnt(0)" ::: "memory");
}

__device__ __forceinline__ void phase0(const Args& a, unsigned char* smem, int tid, int lane, int wave) {
    const int gw = blockIdx.x * 8 + wave, NGW = gridDim.x * 8;
    float* sv = (float*)(smem + 69632);
    for (int i = tid; i < 3 * 2048; i += 512) { const int j = i >> 11, k = i & 2047; const float v = (j < 2) ? a.c[j * 2048 + k] : a.c_ctx[k]; sv[i] = silu_f(v); }
    __syncthreads();
    float* MOD = (float*)(a.ws + WS_MOD);
    for (int it = gw; it < 1536; it += NGW) {
        const int ks = it / 24, cb = it % 24, k0 = ks * 32;
        const float* wp = a.w_mod + (size_t)k0 * 6144 + cb * 256 + lane * 4;
        f32x4 a0 = {0.f, 0.f, 0.f, 0.f}, a1 = a0, a2 = a0;
#pragma unroll 8
        for (int kk = 0; kk < 32; ++kk) { const f32x4 w = *(const f32x4*)(wp + (size_t)kk * 6144);
            a0 += w * sv[k0 + kk]; a1 += w * sv[2048 + k0 + kk]; a2 += w * sv[4096 + k0 + kk]; }
        float* mo = MOD + cb * 256 + lane * 4;
#pragma unroll
        for (int e = 0; e < 4; ++e) { __hip_atomic_fetch_add(mo + e, a0[e], __ATOMIC_RELAXED, __HIP_MEMORY_SCOPE_AGENT);
            __hip_atomic_fetch_add(mo + 6144 + e, a1[e], __ATOMIC_RELAXED, __HIP_MEMORY_SCOPE_AGENT);
            __hip_atomic_fetch_add(mo + 12288 + e, a2[e], __ATOMIC_RELAXED, __HIP_MEMORY_SCOPE_AGENT); }
    }
    float* scr = (float*)(smem + wave * 8448);
    bf16_t* WinT = (bf16_t*)((unsigned char*)a.out + DO_WIN);
    constexpr int I_IN = 32 * 449, I_A = 16 * 64, I_B = 32 * 64, I_O = 32 * 64;
    for (int it = gw; it < I_IN + I_A + I_B + I_O; it += NGW) {
        int r = it;
        if (r < I_IN) { const int kb = r / 449, nb = r % 449, n0 = nb * 32;
            const int drow = n0 < 10240 ? n0 : (n0 < 10272 ? 14336 + (n0 - 10240) : n0 - 32);
            transpose_item(a.w_in, 14368, 2048, WinT, kb * 64, n0, drow, scr, lane); continue; }
        r -= I_IN;
        if (r < I_A) { transpose_item(a.w_br_a, 2048, 1024, (bf16_t*)(a.ws + WS_WA), (r >> 6) * 64, (r & 63) * 32, (r & 63) * 32, scr, lane); continue; }
        r -= I_A;
        if (r < I_B) { transpose_item(a.w_br_b, 2048, 2048, (bf16_t*)(a.ws + WS_WB), (r >> 6) * 64, (r & 63) * 32, (r & 63) * 32, scr, lane); continue; }
        r -= I_B;
        transpose_item(a.w_out, 2048, 2048, (bf16_t*)(a.ws + WS_WO), (r >> 6) * 64, (r & 63) * 32, (r & 63) * 32, scr, lane);
    }
    { u32x4* z = (u32x4*)(WinT + (size_t)14368 * 2048); const u32x4 zero = {0u, 0u, 0u, 0u};
      for (int i = blockIdx.x * 512 + tid; i < 224 * 256; i += gridDim.x * 512) z[i] = zero; }
}

__device__ __forceinline__ void phase1(const Args& a, unsigned char* smem, int tid, int lane, int wave) {
    const int gw = blockIdx.x * 8 + wave, NGW = gridDim.x * 8;
    float* ss = (float*)smem;
    const float* MOD = (const float*)(a.ws + WS_MOD);
    for (int i = tid; i < 3 * 2048; i += 512) { const int j = i >> 11, k = i & 2047;
        ss[(j * 2 + 0) * 2048 + k] = 1.f + MOD[j * 6144 + 2048 + k] + a.b_mod[2048 + k];
        ss[(j * 2 + 1) * 2048 + k] = MOD[j * 6144 + k] + a.b_mod[k]; }
    __syncthreads();
    bf16_t* H = (bf16_t*)((unsigned char*)a.out + DO_H);
    for (int r = gw; r < MR; r += NGW) {
        const float* src = r < MLAT ? a.x + (size_t)r * 2048 : a.ctx + (size_t)(r - MLAT) * 2048;
        const int j = r < MLAT ? (r >> 14) : 2;
        const f32x4* xr = (const f32x4*)src + lane;
        f32x4 v[8]; float s = 0.f;
#pragma unroll
        for (int q = 0; q < 8; ++q) { v[q] = __builtin_nontemporal_load(xr + 64 * q); s += (v[q].x + v[q].y) + (v[q].z + v[q].w); }
        const float mean = wave_sum(s) * (1.f / 2048.f); float s2 = 0.f;
#pragma unroll
        for (int q = 0; q < 8; ++q) { v[q] = v[q] - mean; s2 += (v[q].x * v[q].x + v[q].y * v[q].y) + (v[q].z * v[q].z + v[q].w * v[q].w); }
        const float rstd = rsqrtf(wave_sum(s2) * (1.f / 2048.f) + 1e-6f);
        u32x2* o8 = (u32x2*)(H + (size_t)r * 2048) + lane;
        const f32x4* sc = (const f32x4*)(ss + (j * 2 + 0) * 2048) + lane; const f32x4* sh = (const f32x4*)(ss + (j * 2 + 1) * 2048) + lane;
#pragma unroll
        for (int q = 0; q < 8; ++q) { const f32x4 y = v[q] * rstd * sc[64 * q] + sh[64 * q]; u32x2 o; o.x = pk2(y.x, y.y); o.y = pk2(y.z, y.w); o8[64 * q] = o; }
    }
}

struct EpiProj {
    static constexpr bool PERM = true, AFTER_DRAIN = false;
    unsigned char* ws; unsigned char* lds_epi;
    __device__ __forceinline__ void operator()(const f32x4 (&acc)[2][2][4][2], const pg8::Unit& u, int wr, int wc, int fr, int fq) const {
        const int pn = u.pn, row0 = u.pm * 256 + wr * 64 + fr;
        if (pn == 56) {
            if (wc == 0) { float* BG = (float*)(ws + WS_BG);
#pragma unroll
                for (int ai = 0; ai < 2; ++ai)
#pragma unroll
                    for (int m = 0; m < 4; ++m) { float* p = BG + (size_t)(row0 + ai * 128 + m * 16) * 32 + 8 * fq;
                        *(f32x4*)p = acc[ai][0][m][0]; *(f32x4*)(p + 4) = acc[ai][0][m][1]; } }
            return;
        }
        const bool tr = (pn >= 8 && pn < 12) || (pn >= 24 && pn < 32);
        unsigned char* base; int colt, ld;
        if (pn < 24) { base = ws + WS_AQ + (size_t)(pn >> 2) * SZ1; colt = (pn & 3) * 256; ld = 1024; }
        else { base = ws + WS_BVT + (size_t)((pn - 24) >> 3) * SZ2; colt = ((pn - 24) & 7) * 256; ld = 2048; }
        if (tr) {
            bf16_t* VO = (bf16_t*)base; const bool isb = pn >= 24;
            bf16_t* T = (bf16_t*)(lds_epi + (wr * 4 + wc) * 2048);
            const int lane = fq * 16 + fr, col = lane & 31, half = lane >> 5;
#pragma unroll
            for (int ai = 0; ai < 2; ++ai)
#pragma unroll
                for (int m = 0; m < 4; ++m)
#pragma unroll
                    for (int bj = 0; bj < 2; ++bj) {
#pragma unroll
                        for (int n = 0; n < 2; ++n) { const f32x4 v = acc[ai][bj][m][n]; const unsigned w0 = pk2(v[0], v[1]), w1 = pk2(v[2], v[3]);
                            bf16_t* p = T + (8 * fq + 4 * n) * 24 + fr;
                            p[0] = (bf16_t)(w0 & 0xffffu); p[24] = (bf16_t)(w0 >> 16); p[48] = (bf16_t)(w1 & 0xffffu); p[72] = (bf16_t)(w1 >> 16); }
                        asm volatile("s_waitcnt lgkmcnt(0)" ::: "memory");
                        const u32x4 w = *(const u32x4*)(T + col * 24 + half * 8);
                        asm volatile("s_waitcnt lgkmcnt(0)" ::: "memory");
                        const int dvg = colt + bj * 128 + wc * 32 + col;
                        if (isb) { const size_t gc = (size_t)u.pm * 4 + ai * 2 + wr;
                            *(u32x4*)(VO + ((((gc * 4 + (dvg >> 9)) * 16 + ((dvg >> 5) & 15)) * 4 + m) * 64 + half * 32 + col) * 8) = w; }
                        else *(u32x4*)(VO + (size_t)dvg * MR + (size_t)(u.pm * 256 + ai * 128 + wr * 64 + m * 16 + half * 8)) = w;
                    }
        } else {
            bf16_t* O = (bf16_t*)base; const int col0 = colt + wc * 32 + 8 * fq;
#pragma unroll
            for (int ai = 0; ai < 2; ++ai)
#pragma unroll
                for (int m = 0; m < 4; ++m) { bf16_t* rowp = O + (size_t)(row0 + ai * 128 + m * 16) * ld + col0;
#pragma unroll
                    for (int bj = 0; bj < 2; ++bj) { const f32x4 v0 = acc[ai][bj][m][0], v1 = acc[ai][bj][m][1];
                        u32x4 w; w.x = pk2(v0[0], v0[1]); w.y = pk2(v0[2], v0[3]); w.z = pk2(v1[0], v1[1]); w.w = pk2(v1[2], v1[3]);
                        *(u32x4*)(rowp + bj * 128) = w; } }
        }
    }
};

struct EpiMerge1 {
    static constexpr bool PERM = true, AFTER_DRAIN = false;
    bf16_t* G;
    __device__ __forceinline__ void operator()(const f32x4 (&acc)[2][2][4][2], const pg8::Unit& u, int wr, int wc, int fr, int fq) const {
        const int row0 = u.pm * 256 + wr * 64 + fr, col0 = u.pn * 256 + wc * 32 + 8 * fq;
#pragma unroll
        for (int ai = 0; ai < 2; ++ai) {
            u32x4 gb[4][2];
#pragma unroll
            for (int m = 0; m < 4; ++m)
#pragma unroll
                for (int bj = 0; bj < 2; ++bj) gb[m][bj] = *(const u32x4*)(G + (size_t)(row0 + ai * 128 + m * 16) * 2048 + col0 + bj * 128);
            asm volatile("" ::: "memory");
#pragma unroll
            for (int m = 0; m < 4; ++m) { bf16_t* rowp = G + (size_t)(row0 + ai * 128 + m * 16) * 2048 + col0;
#pragma unroll
                for (int bj = 0; bj < 2; ++bj) { const u32x4 g = gb[m][bj]; const f32x4 v0 = acc[ai][bj][m][0], v1 = acc[ai][bj][m][1];
                    u32x4 w; w.x = pk2(sigmoid_f(bflo(g.x)) * v0[0], sigmoid_f(bfhi(g.x)) * v0[1]); w.y = pk2(sigmoid_f(bflo(g.y)) * v0[2], sigmoid_f(bfhi(g.y)) * v0[3]);
                    w.z = pk2(sigmoid_f(bflo(g.z)) * v1[0], sigmoid_f(bfhi(g.z)) * v1[1]); w.w = pk2(sigmoid_f(bflo(g.w)) * v1[2], sigmoid_f(bfhi(g.w)) * v1[3]);
                    *(u32x4*)(rowp + bj * 128) = w; } }
        }
    }
};
struct EpiMerge2 {
    static constexpr bool PERM = true, AFTER_DRAIN = false;
    const bf16_t* T; const bf16_t* G; bf16_t* O;
    __device__ __forceinline__ void operator()(const f32x4 (&acc)[2][2][4][2], const pg8::Unit& u, int wr, int wc, int fr, int fq) const {
        const int row0 = u.pm * 256 + wr * 64 + fr, col0 = u.pn * 256 + wc * 32 + 8 * fq;
#pragma unroll
        for (int ai = 0; ai < 2; ++ai)
#pragma unroll
          for (int mp = 0; mp < 2; ++mp) {
            u32x4 gb[2][2], tb[2][2];
#pragma unroll
            for (int mm = 0; mm < 2; ++mm)
#pragma unroll
                for (int bj = 0; bj < 2; ++bj) { const size_t ro = (size_t)(row0 + ai * 128 + (mp * 2 + mm) * 16) * 2048 + col0 + bj * 128; gb[mm][bj] = *(const u32x4*)(G + ro); tb[mm][bj] = *(const u32x4*)(T + ro); }
            asm volatile("" ::: "memory");
#pragma unroll
            for (int mm = 0; mm < 2; ++mm) { const int m = mp * 2 + mm; const size_t ro = (size_t)(row0 + ai * 128 + m * 16) * 2048 + col0;
#pragma unroll
                for (int bj = 0; bj < 2; ++bj) { const u32x4 g = gb[mm][bj]; const u32x4 t = tb[mm][bj];
                    const f32x4 v0 = acc[ai][bj][m][0], v1 = acc[ai][bj][m][1];
                    u32x4 w; w.x = pk2(bflo(t.x) + sigmoid_f(bflo(g.x)) * v0[0], bfhi(t.x) + sigmoid_f(bfhi(g.x)) * v0[1]);
                    w.y = pk2(bflo(t.y) + sigmoid_f(bflo(g.y)) * v0[2], bfhi(t.y) + sigmoid_f(bfhi(g.y)) * v0[3]);
                    w.z = pk2(bflo(t.z) + sigmoid_f(bflo(g.z)) * v1[0], bfhi(t.z) + sigmoid_f(bfhi(g.z)) * v1[1]);
                    w.w = pk2(bflo(t.w) + sigmoid_f(bflo(g.w)) * v1[2], bfhi(t.w) + sigmoid_f(bfhi(g.w)) * v1[3]);
                    *(u32x4*)(O + ro + bj * 128) = w; } }
          }
    }
};
struct EpiOut {
    static constexpr bool PERM = true, AFTER_DRAIN = false;
    const float* x; const float* MOD; const float* b_mod; bf16_t* out;
    __device__ __forceinline__ void operator()(const f32x4 (&acc)[2][2][4][2], const pg8::Unit& u, int wr, int wc, int fr, int fq) const {
        const int row0 = u.pm * 256 + wr * 64 + fr, col0 = u.pn * 256 + wc * 32 + 8 * fq;
        const int b = (u.pm * 256) >> 14;
        f32x4 gt[2][2];
#pragma unroll
        for (int bj = 0; bj < 2; ++bj)
#pragma unroll
            for (int n = 0; n < 2; ++n) gt[bj][n] = *(const f32x4*)(MOD + b * 6144 + 4096 + col0 + bj * 128 + 4 * n) + *(const f32x4*)(b_mod + 4096 + col0 + bj * 128 + 4 * n);
#pragma unroll
        for (int ai = 0; ai < 2; ++ai)
#pragma unroll
          for (int mp = 0; mp < 2; ++mp) {
            f32x4 xb[2][2][2];
#pragma unroll
            for (int mm = 0; mm < 2; ++mm)
#pragma unroll
                for (int bj = 0; bj < 2; ++bj)
#pragma unroll
                    for (int n = 0; n < 2; ++n) xb[mm][bj][n] = *(const f32x4*)(x + (size_t)(row0 + ai * 128 + (mp * 2 + mm) * 16) * 2048 + col0 + bj * 128 + 4 * n);
            asm volatile("" ::: "memory");
#pragma unroll
            for (int mm = 0; mm < 2; ++mm) { const int m = mp * 2 + mm; const size_t ro = (size_t)(row0 + ai * 128 + m * 16) * 2048 + col0;
#pragma unroll
                for (int bj = 0; bj < 2; ++bj) {
                    const f32x4 v0 = xb[mm][bj][0] * 1.189207115002721f + gt[bj][0] * acc[ai][bj][m][0], v1 = xb[mm][bj][1] * 1.189207115002721f + gt[bj][1] * acc[ai][bj][m][1];
                    u32x4 w; w.x = pkh2(v0[0], v0[1]); w.y = pkh2(v0[2], v0[3]); w.z = pkh2(v1[0], v1[1]); w.w = pkh2(v1[2], v1[3]);
                    *(u32x4*)(out + ro + bj * 128) = w; } }
          }
    }
};

__device__ __forceinline__ void phase_attn(const Args& a, unsigned char* smem, int tid, int lane, int wave, bf16_t* Yout) {
    bf16_t* Ks = (bf16_t*)smem;
    bf16_t* Vs = (bf16_t*)(smem + 36864);
    float* rpb_s = (float*)(smem + 70656);
    const bf16_t* AQ = (const bf16_t*)(a.ws + WS_AQ); const bf16_t* AK = (const bf16_t*)(a.ws + WS_AK);
    const bf16_t* AVT = (const bf16_t*)(a.ws + WS_AVT); const bf16_t* AZ = (const bf16_t*)(a.ws + WS_AZ);
    const int q16 = lane & 15, g = lane >> 4, wo = 8 * (q16 >> 2) + (q16 & 3);
    for (int bu = blockIdx.x; bu < 256; bu += gridDim.x) {
        const int combo = bu >> 3, b = combo >> 4, h = combo & 15, rbase = (bu & 7) * 32;
        __syncthreads();
#pragma unroll
        for (int j = 0; j < 4; ++j) { const int c = tid + 512 * j;
            { const int key = c >> 3, ch = c & 7; *(u32x4*)(Ks + key * 72 + ch * 8) = *(const u32x4*)(AK + (size_t)(MLAT + b * 256 + key) * 1024 + h * 64 + ch * 8); }
            { const int d = c >> 5, ch = c & 31; *(u32x4*)(Vs + d * 264 + ch * 8) = *(const u32x4*)(AVT + (size_t)(h * 64 + d) * MR + MLAT + b * 256 + ch * 8); } }
        if (tid < 465) rpb_s[tid] = a.na_rpb[h * 465 + tid];
        __syncthreads();
        for (int u = wave; u < 128; u += 8) {
            const int r = rbase + (u >> 2), qt = u & 3;
            const int c0 = qt * 16, kc0 = min(max(c0 - 8, 0), 32), rs = min(max(r - 4, 0), 248);
            const int qc = c0 + q16, cs = min(max(qc - 8, 0), 48);
            const size_t qrow = (size_t)b * 16384 + r * 64 + qc;
            const bf16x8 qf0 = *(const bf16x8*)(AQ + qrow * 1024 + h * 64 + 8 * g), qf1 = *(const bf16x8*)(AQ + qrow * 1024 + h * 64 + 32 + 8 * g);
            f32x4 st[32];
            bf16x8 kbuf[1][8];
#define ATT_KLOAD(bt, dstb) do { _Pragma("unroll") for (int ii_ = 0; ii_ < 2; ++ii_) _Pragma("unroll") for (int hf_ = 0; hf_ < 2; ++hf_) { \
                const size_t krow_ = (size_t)b * 16384 + (rs + (bt) * 2 + ii_) * 64 + kc0 + wo + 4 * hf_; \
                const bf16_t* kp_ = AK + krow_ * 1024 + h * 64 + 8 * g; \
                kbuf[dstb][(ii_ * 2 + hf_) * 2] = *(const bf16x8*)kp_; kbuf[dstb][(ii_ * 2 + hf_) * 2 + 1] = *(const bf16x8*)(kp_ + 32); } } while (0)
#pragma unroll
            for (int bt = 0; bt < 4; ++bt) {
                ATT_KLOAD(bt, 0);
                asm volatile("" ::: "memory");
#pragma unroll
                for (int ii = 0; ii < 2; ++ii) {
                    const int i = bt * 2 + ii;
                    const float* rp = rpb_s + (rs + i - r + 7) * 31;
#pragma unroll
                    for (int hf = 0; hf < 2; ++hf) {
                        f32x4 s = {0.f, 0.f, 0.f, 0.f};
                        s = mfma16(kbuf[0][(ii * 2 + hf) * 2], qf0, s); s = mfma16(kbuf[0][(ii * 2 + hf) * 2 + 1], qf1, s);
#pragma unroll
                        for (int e = 0; e < 4; ++e) { const int kc = kc0 + 8 * g + 4 * hf + e; const bool ok = (kc >= cs) && (kc < cs + 16);
                            const int dc = min(max(kc - qc + 15, 0), 30);
                            s[e] = ok ? s[e] * 0.125f + rp[dc] : -1e30f; }
                        st[i * 2 + hf] = s;
                    }
                }
            }
#undef ATT_KLOAD
            bf16x8 vbuf[1][8];
#define ATT_VLOAD(bt, dstb) do { _Pragma("unroll") for (int pp_ = 0; pp_ < 2; ++pp_) { \
                const size_t tokb_ = (size_t)b * 16384 + (rs + (bt) * 2 + pp_) * 64 + kc0 + 8 * g; \
                _Pragma("unroll") for (int mt_ = 0; mt_ < 4; ++mt_) vbuf[dstb][pp_ * 4 + mt_] = *(const bf16x8*)(AVT + (size_t)(h * 64 + mt_ * 16 + q16) * MR + tokb_); } } while (0)
#pragma unroll
            for (int c = 0; c < 8; ++c)
#pragma unroll
                for (int hf = 0; hf < 2; ++hf) {
                    const bf16_t* kp = Ks + (c * 32 + wo + 4 * hf) * 72 + 8 * g;
                    const bf16x8 k0 = *(const bf16x8*)kp, k1 = *(const bf16x8*)(kp + 32);
                    f32x4 s = {0.f, 0.f, 0.f, 0.f};
                    s = mfma16(k0, qf0, s); s = mfma16(k1, qf1, s);
                    st[16 + c * 2 + hf] = s * 0.125f;
                }
            float mx = -1e30f;
#pragma unroll
            for (int t = 0; t < 32; ++t) mx = fmaxf(fmaxf(fmaxf(st[t][0], st[t][1]), fmaxf(st[t][2], st[t][3])), mx);
            mx = fmaxf(mx, __shfl_xor(mx, 16)); mx = fmaxf(mx, __shfl_xor(mx, 32));
            float l = 0.f;
#pragma unroll
            for (int t = 0; t < 32; ++t) {
#pragma unroll
                for (int e = 0; e < 4; ++e) { const float p = __expf(st[t][e] - mx); st[t][e] = p; l += p; } }
            l += __shfl_xor(l, 16); l += __shfl_xor(l, 32);
            bf16x8 pb[16];
#pragma unroll
            for (int p = 0; p < 16; ++p) { u32x4 pw; pw.x = pk2(st[2 * p][0], st[2 * p][1]); pw.y = pk2(st[2 * p][2], st[2 * p][3]); pw.z = pk2(st[2 * p + 1][0], st[2 * p + 1][1]); pw.w = pk2(st[2 * p + 1][2], st[2 * p + 1][3]);
                pb[p] = __builtin_bit_cast(bf16x8, pw); }
            f32x4 o[4];
#pragma unroll
            for (int mt = 0; mt < 4; ++mt) o[mt] = (f32x4){0.f, 0.f, 0.f, 0.f};
            bf16x8 vb2[1][16];
#define ATT_VLOAD16(bt, dstb) do { _Pragma("unroll") for (int pp_ = 0; pp_ < 4; ++pp_) { \
                const size_t tokb_ = (size_t)b * 16384 + (rs + (bt) * 4 + pp_) * 64 + kc0 + 8 * g; \
                _Pragma("unroll") for (int mt_ = 0; mt_ < 4; ++mt_) vb2[dstb][pp_ * 4 + mt_] = *(const bf16x8*)(AVT + (size_t)(h * 64 + mt_ * 16 + q16) * MR + tokb_); } } while (0)
            ATT_VLOAD16(0, 0);
            asm volatile("" ::: "memory");
#pragma unroll
            for (int p = 8; p < 16; ++p) {
#pragma unroll
                for (int mt = 0; mt < 4; ++mt) o[mt] = mfma16(*(const bf16x8*)(Vs + (mt * 16 + q16) * 264 + (p - 8) * 32 + 8 * g), pb[p], o[mt]);
            }
            asm volatile("" ::: "memory");
#pragma unroll
            for (int bt = 0; bt < 2; ++bt) {
                if (bt == 1) { ATT_VLOAD16(1, 0); asm volatile("" ::: "memory"); }
#pragma unroll
                for (int pp = 0; pp < 4; ++pp)
#pragma unroll
                    for (int mt = 0; mt < 4; ++mt) o[mt] = mfma16(vb2[0][pp * 4 + mt], pb[bt * 4 + pp], o[mt]);
            }
#undef ATT_VLOAD16
#undef ATT_VLOAD
            const float inv = 1.f / l;
#pragma unroll
            for (int mt = 0; mt < 4; ++mt) {
                const size_t off = qrow * 1024 + h * 64 + mt * 16 + 4 * g;
                const u32x2 z = *(const u32x2*)(AZ + off);
                u32x2 w; w.x = pk2(o[mt][0] * inv * silu_f(bflo(z.x)), o[mt][1] * inv * silu_f(bfhi(z.x)));
                w.y = pk2(o[mt][2] * inv * silu_f(bflo(z.y)), o[mt][3] * inv * silu_f(bfhi(z.y)));
                *(u32x2*)(Yout + off) = w;
            }
        }
    }
}

__device__ __forceinline__ void phase_g0(const Args& a, unsigned char* smem, int tid, int lane, int wave, bf16_t* QEFdst) {
    float* lr = (float*)smem;
    float* w2s = (float*)(smem + 4096);
    float* bs = (float*)(smem + 12288);
    float* lastv = (float*)(smem + 12800);
    float* G = (float*)(smem + 16384);
    bf16_t* KDs = (bf16_t*)(smem + 16384);
    bf16_t* QEs = (bf16_t*)(smem + 49152);
    bf16_t* KEs = (bf16_t*)(smem + 82944);
    const bf16_t* BQ = (const bf16_t*)(a.ws + WS_BQ); const bf16_t* BK = (const bf16_t*)(a.ws + WS_BK);
    const float* BG = (const float*)(a.ws + WS_BG);
    bf16_t* ATT = (bf16_t*)(a.ws + WS_ATT); float* DL = (float*)(a.ws + WS_DL);
    const int q16 = lane & 15, g = lane >> 4;
    for (int u = blockIdx.x; u < 2080; u += gridDim.x) {
        const int gc = u >> 2, h = u & 3, row0 = gc * 64; const bool is_lat = gc < 512; const int n_l = gc & 255;
        float qr[2][16], kr[2][16];
#pragma unroll
        for (int it = 0; it < 2; ++it) {
            const int item = tid + 512 * it, t = item >> 4, hf = (item >> 3) & 1, p8 = item & 7, i1 = hf * 128 + p8 * 8;
            const size_t off = (size_t)(row0 + t) * 1024 + h * 256 + i1;
            const u32x4 q1 = *(const u32x4*)(BQ + off), q2 = *(const u32x4*)(BQ + off + 64), k1 = *(const u32x4*)(BK + off), k2 = *(const u32x4*)(BK + off + 64);
            const float pos = hf ? (float)t : (float)n_l;
#pragma unroll
            for (int e = 0; e < 8; ++e) {
                float cs = 1.f, sn = 0.f;
                if (is_lat) { const float ang = pos * exp2f(-(float)(p8 * 8 + e) * 0.20762050593046014f); cs = __cosf(ang); sn = __sinf(ang); }
                const unsigned uq1 = q1[e >> 1], uq2 = q2[e >> 1], uk1 = k1[e >> 1], uk2 = k2[e >> 1];
                const float a1 = (e & 1) ? bfhi(uq1) : bflo(uq1), a2 = (e & 1) ? bfhi(uq2) : bflo(uq2);
                const float b1 = (e & 1) ? bfhi(uk1) : bflo(uk1), b2 = (e & 1) ? bfhi(uk2) : bflo(uk2);
                qr[it][e] = (a1 * cs - a2 * sn) * 0.0625f; qr[it][8 + e] = (a1 * sn + a2 * cs) * 0.0625f;
                kr[it][e] = b1 * cs - b2 * sn; kr[it][8 + e] = b1 * sn + b2 * cs;
            }
        }
#pragma unroll 1
        for (int dir = 0; dir < 2; ++dir) {
            { const int idx = tid * 2, t = idx >> 4, r = idx & 15; *(f32x2*)(lr + idx) = *(const f32x2*)(BG + (size_t)(row0 + t) * 32 + dir * 16 + r); }
            { const int idx = tid * 4, r = idx >> 7, p = idx & 127; *(f32x4*)(w2s + idx) = *(const f32x4*)(a.w_gate2 + (size_t)(dir * 16 + r) * 512 + h * 128 + p); }
            if (tid < 128) bs[tid] = a.b_gate[dir * 512 + h * 128 + tid];
            __syncthreads();
            { const int p = tid & 127, tq = tid >> 7;
#pragma unroll 4
              for (int i = 0; i < 16; ++i) { const int t = tq + 4 * i; float z = bs[p];
#pragma unroll
                  for (int r = 0; r < 16; ++r) z += lr[t * 16 + r] * w2s[r * 128 + p];
                  G[t * 128 + p] = (fminf(z, 0.f) - __logf(1.f + __expf(-fabsf(z)))) * 0.0625f; } }
            __syncthreads();
            {
                const int p = tid & 127, seg = tid >> 7; float v[16]; float run = 0.f;
#pragma unroll
                for (int s = 0; s < 16; ++s) { const int sidx = seg * 16 + s, t = dir ? 63 - sidx : sidx; run += G[t * 128 + p]; v[s] = run; }
                float* segs = w2s;
                __syncthreads();
                segs[seg * 128 + p] = run;
                __syncthreads();
                float off = 0.f;
#pragma unroll
                for (int q = 0; q < 3; ++q) off += (q < seg) ? segs[q * 128 + p] : 0.f;
#pragma unroll
                for (int s = 0; s < 16; ++s) { const int sidx = seg * 16 + s, t = dir ? 63 - sidx : sidx; G[t * 128 + p] = v[s] + off; }
                if (seg == 3) lastv[p] = run + off;
            }
            __syncthreads();
            if (tid < 256) { const int p = (tid >> 7) * 64 + (tid & 63); DL[((size_t)(dir * 520 + gc) * 4 + h) * 256 + tid] = __expf(lastv[p]); }
            unsigned kdp[2][8];
#pragma unroll
            for (int it = 0; it < 2; ++it) {
                const int item = tid + 512 * it, t = item >> 4, hf = (item >> 3) & 1, p8 = item & 7, i1 = hf * 128 + p8 * 8, gcol = hf * 64 + p8 * 8;
                float qe[16], ke[16], kd[16];
#pragma unroll
                for (int e = 0; e < 8; ++e) { const float cum = G[t * 128 + gcol + e], lst = lastv[gcol + e];
                    const float eq = __expf(cum), ek = __expf(-cum), ed = __expf(lst - cum);
                    qe[e] = qr[it][e] * eq; qe[8 + e] = qr[it][8 + e] * eq; ke[e] = kr[it][e] * ek; ke[8 + e] = kr[it][8 + e] * ek; kd[e] = kr[it][e] * ed; kd[8 + e] = kr[it][8 + e] * ed; }
                u32x4 w;
                w.x = pk2(qe[0], qe[1]); w.y = pk2(qe[2], qe[3]); w.z = pk2(qe[4], qe[5]); w.w = pk2(qe[6], qe[7]); *(u32x4*)(QEs + t * 264 + i1) = w;
                w.x = pk2(qe[8], qe[9]); w.y = pk2(qe[10], qe[11]); w.z = pk2(qe[12], qe[13]); w.w = pk2(qe[14], qe[15]); *(u32x4*)(QEs + t * 264 + i1 + 64) = w;
                w.x = pk2(ke[0], ke[1]); w.y = pk2(ke[2], ke[3]); w.z = pk2(ke[4], ke[5]); w.w = pk2(ke[6], ke[7]); *(u32x4*)(KEs + t * 264 + i1) = w;
                w.x = pk2(ke[8], ke[9]); w.y = pk2(ke[10], ke[11]); w.z = pk2(ke[12], ke[13]); w.w = pk2(ke[14], ke[15]); *(u32x4*)(KEs + t * 264 + i1 + 64) = w;
#pragma unroll
                for (int e = 0; e < 8; ++e) kdp[it][e] = pk2(kd[2 * e], kd[2 * e + 1]);
            }
            __syncthreads();
#pragma unroll
            for (int it = 0; it < 2; ++it) {
                const int item = tid + 512 * it, t = item >> 4, hf = (item >> 3) & 1, p8 = item & 7, i1 = hf * 128 + p8 * 8;
                u32x4 w; w.x = kdp[it][0]; w.y = kdp[it][1]; w.z = kdp[it][2]; w.w = kdp[it][3]; *(u32x4*)(KDs + t * 256 + i1) = w;
                w.x = kdp[it][4]; w.y = kdp[it][5]; w.z = kdp[it][6]; w.w = kdp[it][7]; *(u32x4*)(KDs + t * 256 + i1 + 64) = w;
            }
            if (is_lat) {
                const int mi = wave >> 1, nb = (wave & 1) * 2;
                f32x4 c0 = {0.f, 0.f, 0.f, 0.f}, c1 = c0;
#pragma unroll
                for (int ks = 0; ks < 8; ++ks) {
                    const bf16x8 A = *(const bf16x8*)(QEs + (16 * mi + q16) * 264 + ks * 32 + 8 * g);
                    const bf16x8 B0 = *(const bf16x8*)(KEs + (16 * nb + q16) * 264 + ks * 32 + 8 * g);
                    const bf16x8 B1 = *(const bf16x8*)(KEs + (16 * (nb + 1) + q16) * 264 + ks * 32 + 8 * g);
                    c0 = mfma16(A, B0, c0); c1 = mfma16(A, B1, c1);
                }
#pragma unroll
                for (int e = 0; e < 4; ++e) { const int t = 16 * mi + 4 * g + e;
                    bf16_t* ab = ATT + ((size_t)(dir * 512 + gc) * 4 + h) * 4096 + (size_t)((t >> 5) * 4) * 512 + (t & 31) * 8;
                    { const int tp = 16 * nb + q16; const bool keep = dir ? (tp >= t) : (tp <= t);
                      ab[(tp >> 4) * 512 + ((tp >> 3) & 1) * 256 + (tp & 7)] = (bf16_t)(pk2(keep ? c0[e] : 0.f, 0.f) & 0xffffu); }
                    { const int tp = 16 * (nb + 1) + q16; const bool keep = dir ? (tp >= t) : (tp <= t);
                      ab[(tp >> 4) * 512 + ((tp >> 3) & 1) * 256 + (tp & 7)] = (bf16_t)(pk2(keep ? c1[e] : 0.f, 0.f) & 0xffffu); }
                }
            }
            __syncthreads();
            if (is_lat) {
                bf16_t* QE = dir ? (bf16_t*)(a.ws + WS_AZ) : QEFdst;
#pragma unroll
                for (int j = 0; j < 4; ++j) { const int c = tid + 512 * j, t = c >> 5, ch = c & 31, blk = ch >> 2, s = (ch >> 1) & 1, hh = ch & 1, srcA = blk * 32 + 16 * s + 4 * hh;
                    const u32x2 lo = *(const u32x2*)(QEs + t * 264 + srcA), hi = *(const u32x2*)(QEs + t * 264 + srcA + 8);
                    u32x4 w; w.x = lo.x; w.y = lo.y; w.z = hi.x; w.w = hi.y;
                    const int slot = ((blk * 2 + (t >> 5)) * 2 + s) * 2 + hh;
                    *(u32x4*)(QE + (size_t)(row0 + slot) * 1024 + h * 256 + (t & 31) * 8) = w; }
            }
            { bf16_t* KDT = (bf16_t*)(a.ws + (dir ? WS_AVT : WS_AK));
#pragma unroll
              for (int j = 0; j < 4; ++j) { const int c = tid + 512 * j, dk = c >> 3, t8 = c & 7;
                  unsigned v[8];
#pragma unroll
                  for (int e = 0; e < 8; ++e) v[e] = KDs[(t8 * 8 + e) * 256 + dk];
                  u32x4 w; w.x = v[0] | (v[1] << 16); w.y = v[2] | (v[3] << 16); w.z = v[4] | (v[5] << 16); w.w = v[6] | (v[7] << 16);
                  *(u32x4*)(KDT + ((((size_t)gc * 4 + h) * 8 + (dk >> 5)) * 4 + (t8 >> 1)) * 512 + ((t8 & 1) * 32 + (dk & 31)) * 8) = w; } }
            __syncthreads();
        }
    }
}

__device__ __forceinline__ void phase_scan(const Args& a, unsigned char* smem, int tid, int lane, int wave) {
    unsigned* red = (unsigned*)smem;
    unsigned char* vst = smem + 65536;
    unsigned char* dst = smem + 73728;
    const int l31 = lane & 31, hh = lane >> 5, kb = wave;
    for (int wu = blockIdx.x; wu < 256; wu += gridDim.x) {
        const int combo = (wu & 7) * 2 + (wu >> 7), sl = (wu >> 3) & 15;
        const int b = combo >> 3, h = (combo >> 1) & 3, dir = combo & 1;
        const bf16_t* QE = (const bf16_t*)(a.ws + (dir ? WS_AZ : WS_BQ));
        const bf16_t* KDT = (const bf16_t*)(a.ws + (dir ? WS_AVT : WS_AK));
        const bf16_t* ATT = (const bf16_t*)(a.ws + WS_ATT) + (size_t)dir * 512 * 4 * 4096;
        const float* DL = (const float*)(a.ws + WS_DL) + (size_t)dir * 520 * 1024;
        const bf16_t* BVF = (const bf16_t*)(a.ws + WS_BVT) + (size_t)lane * 8;
        bf16_t* O = (bf16_t*)((unsigned char*)a.out + (dir ? DO_OB : DO_OF));
        f32x16 S;
#pragma unroll
        for (int i = 0; i < 16; ++i) S[i] = 0.f;
        bf16x8 vB[4], qeA[4], atA; f32x4 dl[4];
        bf16x8 nqe[4], nat;
        u32x4 gcur = {0u, 0u, 0u, 0u}, gnxt = {0u, 0u, 0u, 0u};
#define SCAN_GC(step) ((step) < 4 ? 512 + b * 4 + (dir ? 3 - (step) : (step)) : b * 256 + (dir ? 259 - (step) : (step) - 4))
#define SCAN_LOAD(step, QE_, AT_) do { const int gc_ = SCAN_GC(step); const size_t rq_ = gc_ < 512 ? (size_t)gc_ * 64 : 0; \
        _Pragma("unroll") for (int mt_ = 0; mt_ < 2; ++mt_) _Pragma("unroll") for (int s_ = 0; s_ < 2; ++s_) \
            QE_[mt_ * 2 + s_] = *(const bf16x8*)(QE + (rq_ + (((kb * 2 + mt_) * 2 + s_) * 2 + hh)) * 1024 + h * 256 + l31 * 8); \
        AT_ = *(const bf16x8*)(ATT + (((rq_ >> 6) * 4 + h) * 8 + wave) * 512 + lane * 8); } while (0)
#define SCAN_GLOAD(step, G_) do { const int gc_ = SCAN_GC(step); \
        if (wave < 4) G_ = *(const u32x4*)(BVF + ((((size_t)gc_ * 4 + h) * 16 + sl) * 4 + wave) * 512); \
        else if (wave == 4) G_ = *(const u32x4*)(DL + ((size_t)gc_ * 4 + h) * 256 + lane * 4); } while (0)
#define SCAN_GSTORE(buf, G_) do { if (wave < 4) *(u32x4*)(vst + (((buf) * 4 + wave) * 64 + lane) * 16) = G_; \
        else if (wave == 4) *(u32x4*)(dst + (buf) * 1024 + lane * 16) = G_; } while (0)
#define SCAN_LREAD(buf, VB_, DL_) do { _Pragma("unroll") for (int q_ = 0; q_ < 4; ++q_) { \
        VB_[q_] = *(const bf16x8*)(vst + (((buf) * 4 + q_) * 64 + lane) * 16); \
        DL_[q_] = *(const f32x4*)(dst + (buf) * 1024 + (kb * 32 + 8 * q_ + 4 * hh) * 4); } } while (0)
        const unsigned char* scb; unsigned scsg;
        { const int q16s = sl * 16 + (lane & 15);
          if (wave == 5) { if (lane < 16) { scb = (const unsigned char*)KDT + (size_t)h * 32768 + (size_t)q16s * 128; scsg = 131072u; }
                           else if (lane < 32) { scb = (const unsigned char*)QE + (size_t)h * 512 + (size_t)(q16s >> 2) * 2048 + (q16s & 3) * 128; scsg = 131072u; }
                           else if (lane < 36) { scb = (const unsigned char*)ATT + (size_t)h * 8192 + (size_t)(sl * 4 + lane - 32) * 128; scsg = 32768u; }
                           else { scb = (const unsigned char*)DL + (size_t)h * 1024 + (lane & 7) * 128; scsg = 4096u; } }
          else if (wave == 6) { scb = (const unsigned char*)(a.ws + WS_BVT) + (size_t)(h * 16 + sl) * 4096 + (size_t)(lane & 31) * 128; scsg = 262144u; }
          else { scb = (const unsigned char*)DL + (size_t)h * 1024; scsg = 0u; } }
        unsigned scA = 0u, scB = 0u;
        __syncthreads();
        SCAN_GLOAD(0, gcur); SCAN_GSTORE(0, gcur);
        SCAN_GLOAD(1, gcur);
        SCAN_LOAD(0, qeA, atA);
        __syncthreads();
        SCAN_LREAD(0, vB, dl);
        __builtin_amdgcn_s_waitcnt(0x0F70);
        auto stepf = [&](const int step, unsigned& sc_issue, unsigned& sc_consume) __attribute__((always_inline)) {
            const int nstep = step < 259 ? step + 1 : step, n2 = step < 258 ? step + 2 : 259;
            SCAN_LOAD(nstep, nqe, nat);
            SCAN_GLOAD(n2, gnxt);
#if SCOUT
            { int ss = step + SCOUT; ss = ss > 259 ? 259 : ss; const int gcs = SCAN_GC(ss); sc_issue = *(const unsigned*)(scb + (size_t)gcs * scsg); }
#endif
            const int gc = SCAN_GC(step); const size_t row0 = (size_t)gc * 64;
            bf16x8 kdA[4];
            { const bf16_t* kp = KDT + (((size_t)gc * 4 + h) * 8 + kb) * 2048 + lane * 8;
#pragma unroll
              for (int q = 0; q < 4; ++q) kdA[q] = *(const bf16x8*)(kp + 512 * q); }
            const int rbuf = step & 1, nbuf = rbuf ^ 1;
            if (gc < 512) {
                u32x4 s0, s1;
                s0.x = pk2(S[0], S[1]); s0.y = pk2(S[2], S[3]); s0.z = pk2(S[4], S[5]); s0.w = pk2(S[6], S[7]);
                s1.x = pk2(S[8], S[9]); s1.y = pk2(S[10], S[11]); s1.z = pk2(S[12], S[13]); s1.w = pk2(S[14], S[15]);
                const bf16x8 sb0 = __builtin_bit_cast(bf16x8, s0), sb1 = __builtin_bit_cast(bf16x8, s1);
                f32x16 o0, o1;
#pragma unroll
                for (int i = 0; i < 16; ++i) { o0[i] = 0.f; o1[i] = 0.f; }
                o0 = mfma32(qeA[0], sb0, o0); o0 = mfma32(qeA[1], sb1, o0);
                o1 = mfma32(qeA[2], sb0, o1); o1 = mfma32(qeA[3], sb1, o1);
                const int w3 = wave & 3;
                const bf16x8 vs = w3 == 0 ? vB[0] : (w3 == 1 ? vB[1] : (w3 == 2 ? vB[2] : vB[3]));
                if (wave < 4) o0 = mfma32(atA, vs, o0); else o1 = mfma32(atA, vs, o1);
                unsigned* rb = red + (size_t)(rbuf * 8 + wave) * 1024 + lane; unsigned* rbx = red + (size_t)(rbuf * 8 + wave) * 1024 + (lane ^ 32);
#pragma unroll
                for (int i = 0; i < 8; ++i) { unsigned* w_ = (i & 1) ? rbx : rb; w_[i * 64] = pk2(o0[2 * i], o0[2 * i + 1]); w_[512 + i * 64] = pk2(o1[2 * i], o1[2 * i + 1]); }
            }
            SCAN_GSTORE(nbuf, gcur);
            __syncthreads();
            if (gc < 512) {
                const int tp = tid >> 4, dv2 = (tid & 15) * 2, t = tp * 2, mt = t >> 5, tl = t & 31, pi = 2 * (tl >> 3) + ((tl & 3) >> 1), ln = ((tl >> 2) & 1) * 32 + dv2;
                const unsigned* rp = red + (size_t)rbuf * 8192 + (mt * 8 + pi) * 64 + (ln ^ ((pi & 1) << 5));
                float a0 = 0.f, a1 = 0.f, b0 = 0.f, b1 = 0.f;
#pragma unroll
                for (int w = 0; w < 8; ++w) { const u32x2 v = *(const u32x2*)(rp + w * 1024); a0 += bflo(v.x); b0 += bfhi(v.x); a1 += bflo(v.y); b1 += bfhi(v.y); }
                bf16_t* op = O + (row0 + t) * 2048 + h * 512 + sl * 32 + dv2;
                *(unsigned*)op = pk2(a0, a1); *(unsigned*)(op + 2048) = pk2(b0, b1);
            }
            f32x4 ndl[4]; bf16x8 nvB[4];
            SCAN_LREAD(nbuf, nvB, ndl);
#pragma unroll
            for (int i = 0; i < 16; ++i) S[i] *= dl[i >> 2][i & 3];
#pragma unroll
            for (int ks = 0; ks < 4; ++ks) S = mfma32(kdA[ks], vB[ks], S);
#pragma unroll
            for (int i = 0; i < 4; ++i) { vB[i] = nvB[i]; dl[i] = ndl[i]; qeA[i] = nqe[i]; }
            atA = nat; gcur = gnxt;
#if SCOUT
            asm volatile("" :: "v"(sc_consume));
#endif
        };
#pragma unroll 1
        for (int step = 0; step < 260; step += 2) { stepf(step, scA, scB); stepf(step + 1, scB, scA); }
        asm volatile("" :: "v"(scA), "v"(scB));
        __syncthreads();
#undef SCAN_LREAD
#undef SCAN_GSTORE
#undef SCAN_GLOAD
#undef SCAN_LOAD
#undef SCAN_GC
    }
}

__device__ __forceinline__ void phase_ybz(const Args& a, int lane, int wave) {
    const bf16_t* OF = (const bf16_t*)((unsigned char*)a.out + DO_OF); const bf16_t* OB = (const bf16_t*)((unsigned char*)a.out + DO_OB);
    bf16_t* BZ = (bf16_t*)(a.ws + WS_BZ);
    const f32x4 g0 = *(const f32x4*)(a.norm_g + lane * 8), g1 = *(const f32x4*)(a.norm_g + lane * 8 + 4);
    const int NW = gridDim.x * 8;
    for (int it0 = blockIdx.x * 8 + wave; it0 < MLAT * 4; it0 += 4 * NW) {
        u32x4 f[4], bb[4], z[4]; size_t off[4];
#pragma unroll
        for (int k = 0; k < 4; ++k) { const int it = min(it0 + k * NW, MLAT * 4 - 1); off[k] = (size_t)(it >> 2) * 2048 + (it & 3) * 512 + lane * 8;
            f[k] = __builtin_nontemporal_load((const u32x4*)(OF + off[k])); bb[k] = __builtin_nontemporal_load((const u32x4*)(OB + off[k])); z[k] = __builtin_nontemporal_load((const u32x4*)(BZ + off[k])); }
#pragma unroll
        for (int k = 0; k < 4; ++k) {
            float o[8]; float ss = 0.f;
#pragma unroll
            for (int e = 0; e < 4; ++e) { o[2 * e] = bflo(f[k][e]) + bflo(bb[k][e]); o[2 * e + 1] = bfhi(f[k][e]) + bfhi(bb[k][e]); }
#pragma unroll
            for (int e = 0; e < 8; ++e) ss += o[e] * o[e];
            const float rs = rsqrtf(wave_sum(ss) * (1.f / 512.f) + 1e-6f);
            u32x4 w;
            w.x = pk2(o[0] * rs * g0[0] * silu_f(bflo(z[k].x)), o[1] * rs * g0[1] * silu_f(bfhi(z[k].x)));
            w.y = pk2(o[2] * rs * g0[2] * silu_f(bflo(z[k].y)), o[3] * rs * g0[3] * silu_f(bfhi(z[k].y)));
            w.z = pk2(o[4] * rs * g1[0] * silu_f(bflo(z[k].z)), o[5] * rs * g1[1] * silu_f(bfhi(z[k].z)));
            w.w = pk2(o[6] * rs * g1[2] * silu_f(bflo(z[k].w)), o[7] * rs * g1[3] * silu_f(bfhi(z[k].w)));
            if (it0 + k * NW < MLAT * 4) *(u32x4*)(BZ + off[k]) = w;
        }
    }
}

__device__ __forceinline__ void phase_ln(const Args& a, int lane, int wave) {
    const bf16_t* R = (const bf16_t*)(a.ws + WS_BQ);
    for (int r = blockIdx.x * 8 + wave; r < MLAT; r += gridDim.x * 8) {
        const u32x2* rr = (const u32x2*)(R + (size_t)r * 2048) + lane;
        f32x4* xr = (f32x4*)(a.out + (size_t)r * 2048) + lane;
        u32x2 w[8]; f32x4 v[8]; float s = 0.f;
#pragma unroll
        for (int q = 0; q < 8; ++q) w[q] = __builtin_nontemporal_load(rr + 64 * q);
#pragma unroll
        for (int q = 0; q < 8; ++q) { { const f32x2 p0 = unpkh2(w[q].x), p1 = unpkh2(w[q].y); v[q] = (f32x4){p0.x, p0.y, p1.x, p1.y}; } s += (v[q].x + v[q].y) + (v[q].z + v[q].w); }
        const float mean = wave_sum(s) * (1.f / 2048.f); float s2 = 0.f;
#pragma unroll
        for (int q = 0; q < 8; ++q) { v[q] = v[q] - mean; s2 += (v[q].x * v[q].x + v[q].y * v[q].y) + (v[q].z * v[q].z + v[q].w * v[q].w); }
        const float rstd = rsqrtf(wave_sum(s2) * (1.f / 2048.f) + 1e-6f);
        const f32x4* gg = (const f32x4*)a.ln_g + lane; const f32x4* bb = (const f32x4*)a.ln_b + lane;
#pragma unroll
        for (int q = 0; q < 8; ++q) __builtin_nontemporal_store(v[q] * rstd * gg[64 * q] + bb[64 * q], xr + 64 * q);
    }
}

#define LAS __attribute__((address_space(3)))
#define XB_TMO      128
#define XB_XCNT(j)  (256  + 64 * (j))
#define XB_XSUB(j)  (1280 + 64 * (j))
#define XB_XGEN(j)  (2304 + 64 * (j))
#define XB_TOP      3328
#define XB_TOPGEN   3392
#define XCD_BAR_WORDS 3456
#define XB_SPIN_CAP (1u << 18)

__device__ __forceinline__ unsigned xb_ld(unsigned* p)              { return __hip_atomic_load(p, __ATOMIC_RELAXED, __HIP_MEMORY_SCOPE_AGENT); }
__device__ __forceinline__ unsigned xb_add(unsigned* p, unsigned v) { return __hip_atomic_fetch_add(p, v, __ATOMIC_RELAXED, __HIP_MEMORY_SCOPE_AGENT); }
__device__ __forceinline__ unsigned xb_xcc_id() { return (unsigned)__builtin_amdgcn_s_getreg((3 << 11) | 20) & 0xFu; }
#define XB_SPIN(cond, bar) do { unsigned _sp = 0; while (cond) { __builtin_amdgcn_s_sleep(1); \
    if ((++_sp & 255u) == 0u) { if (xb_ld(&(bar)[XB_TMO])) break; if (_sp > XB_SPIN_CAP) { atomicAdd(&(bar)[XB_TMO], 1u); break; } } } } while (0)

struct XcdBarrier {
    unsigned* bar; unsigned x;
    volatile LAS unsigned* st;
};

__device__ __forceinline__ XcdBarrier xcd_barrier_post(unsigned* bar, volatile LAS unsigned* st) {
    XcdBarrier b; b.bar = bar; b.x = xb_xcc_id(); b.st = st;
    if (threadIdx.x == 0) (void)xb_add(&bar[XB_XCNT(b.x)], 1u);
    return b;
}
__device__ __forceinline__ void xcd_barrier_complete(unsigned* bar, unsigned x, unsigned& nloc, unsigned& nx) {
    const unsigned G = gridDim.x * gridDim.y * gridDim.z;
    unsigned sum, cnt, mine, sp = 0u;
    for (;;) {
        sum = 0u; cnt = 0u; mine = 0u;
#pragma unroll
        for (unsigned j = 0; j < 16; ++j) { const unsigned c = xb_ld(&bar[XB_XCNT(j)]); sum += c; cnt += (c > 0u) ? 1u : 0u; mine = (j == x) ? c : mine; }
        if (sum == G) break;
        __builtin_amdgcn_s_sleep(1);
        if ((++sp & 255u) == 0u) { if (xb_ld(&bar[XB_TMO])) break; if (sp > XB_SPIN_CAP) { atomicAdd(&bar[XB_TMO], 1u); break; } }
    }
    nloc = mine > 0u ? mine : 1u; nx = cnt > 0u ? cnt : 1u;
}

__device__ __forceinline__ void xcd_barrier(const XcdBarrier& b) {
    asm volatile("s_waitcnt vmcnt(0)" ::: "memory");
    __syncthreads();
    if (threadIdx.x == 0) {
        unsigned* bar = b.bar;
        __builtin_amdgcn_s_waitcnt(0);
        unsigned nloc = b.st[0], nx = b.st[1];
        if (nloc == 0u) { xcd_barrier_complete(bar, b.x, nloc, nx); b.st[0] = nloc; b.st[1] = nx; }
        const unsigned old = xb_add(&bar[XB_XSUB(b.x)], 1u);
        const unsigned gen = old / nloc;
        if (old + 1u == (gen + 1u) * nloc) {
            __builtin_amdgcn_fence(__ATOMIC_RELEASE, "agent");
            asm volatile("s_waitcnt vmcnt(0)" ::: "memory");
            const unsigned og = xb_add(&bar[XB_TOP], 1u);
            const unsigned tg = og / nx;
            if (og + 1u == (tg + 1u) * nx) xb_add(&bar[XB_TOPGEN], 1u);
            else XB_SPIN(xb_ld(&bar[XB_TOPGEN]) == tg, bar);
            __builtin_amdgcn_fence(__ATOMIC_ACQUIRE, "agent");
            xb_add(&bar[XB_XGEN(b.x)], 1u);
            asm volatile("s_waitcnt vmcnt(0)" ::: "memory");
        } else {
            XB_SPIN(xb_ld(&bar[XB_XGEN(b.x)]) == gen, bar);
            __builtin_amdgcn_fence(__ATOMIC_ACQUIRE, "agent");
            asm volatile("s_waitcnt vmcnt(0)" ::: "memory");
        }
    }
    __syncthreads();
}

__global__ void __launch_bounds__(512, 2) mk_fwd(Args a) {
    extern __shared__ __attribute__((aligned(16))) unsigned char smem[];
    const int tid = threadIdx.x, lane = tid & 63, wave = __builtin_amdgcn_readfirstlane(tid >> 6);
    const int lo = a.ph_lo, hi = a.ph_hi;
#define IN(k) (lo <= (k) && (k) < hi)
#define SEAM(k) do { if (IN(k) && IN((k) + 1)) { xcd_barrier(xbar); } } while (0)
    PG8_LAS unsigned char* ring = (PG8_LAS unsigned char*)smem;
    volatile LAS unsigned* xst = (volatile LAS unsigned*)((LAS unsigned char*)smem + 147440);
    if (tid < 4) xst[tid] = 0u;
    __syncthreads();
    XcdBarrier xbar = xcd_barrier_post((unsigned*)(a.ws + WS_XBAR), xst);
    if (a.ph_hi > 1000) cg::this_grid().sync();
    if (IN(0)) { phase0(a, smem, tid, lane, wave); }
    SEAM(0);
    if (IN(1)) { phase1(a, smem, tid, lane, wave); if (PROBE_P1 > 1) { __syncthreads(); phase1(a, smem, tid, lane, wave); } }
    SEAM(1);
    if (IN(2)) {
        pg8::Gemm g{(const bf16_t*)((unsigned char*)a.out + DO_H), (const bf16_t*)((unsigned char*)a.out + DO_WIN), MR, NPROJ, 2048};
        pg8::StaticOrder S; S.init(MR, NPROJ, gridDim.x, (int)blockIdx.x);
        EpiProj E{a.ws, smem + 131072};
        pg8::gemm_phase<EpiProj, pg8::StaticOrder, PG8_ALIGN, PG8_SP2>(ring, g, S, E);
        if (PROBE_P2 > 1) { __syncthreads(); pg8::gemm_phase<EpiProj, pg8::StaticOrder, PG8_ALIGN, PG8_SP2>(ring, g, S, E); }
    }
    SEAM(2);
    if (IN(3)) { for (int rep = 0; rep < PROBE_P3D; ++rep) { phase_attn(a, smem, tid, lane, wave, (bf16_t*)a.out); __syncthreads(); }
                 phase_attn(a, smem, tid, lane, wave, (bf16_t*)(a.ws + WS_AQ)); }
    SEAM(3);
    if (IN(4)) { for (int rep = 0; rep < PROBE_P4D; ++rep) { phase_g0(a, smem, tid, lane, wave, (bf16_t*)a.out); __syncthreads(); }
                 phase_g0(a, smem, tid, lane, wave, (bf16_t*)(a.ws + WS_BQ)); }
    SEAM(4);
    if (IN(5)) { for (int rep = 0; rep < PROBE_P5; ++rep) { phase_scan(a, smem, tid, lane, wave); __syncthreads(); } }
    SEAM(5);
    if (IN(6)) { phase_ybz(a, lane, wave); }
    SEAM(6);
    if (IN(7)) {
        pg8::StaticOrder S; S.init(MLAT, 2048, gridDim.x, (int)blockIdx.x);
        { pg8::Gemm g{(const bf16_t*)(a.ws + WS_AQ), (const bf16_t*)(a.ws + WS_WA), MLAT, 2048, 1024};
          EpiMerge1 E{(bf16_t*)(a.ws + WS_MGA)};
          pg8::gemm_phase<EpiMerge1, pg8::StaticOrder, PG8_ALIGN, PG8_SP2>(ring, g, S, E); }
        __syncthreads();
        { pg8::Gemm g{(const bf16_t*)(a.ws + WS_BZ), (const bf16_t*)(a.ws + WS_WB), MLAT, 2048, 2048};
          EpiMerge2 E{(const bf16_t*)(a.ws + WS_MGA), (const bf16_t*)(a.ws + WS_MGB), (bf16_t*)(a.ws + WS_AK)};
          pg8::gemm_phase<EpiMerge2, pg8::StaticOrder, PG8_ALIGN, PG8_SP2>(ring, g, S, E); }
    }
    SEAM(7);
    if (IN(8)) {
        pg8::Gemm g{(const bf16_t*)(a.ws + WS_AK), (const bf16_t*)(a.ws + WS_WO), MLAT, 2048, 2048};
        pg8::StaticOrder S; S.init(MLAT, 2048, gridDim.x, (int)blockIdx.x);
        EpiOut E{a.x, (const float*)(a.ws + WS_MOD), a.b_mod, (bf16_t*)(a.ws + WS_BQ)};
        pg8::gemm_phase<EpiOut, pg8::StaticOrder, PG8_ALIGN, PG8_SP2>(ring, g, S, E);
        if (PROBE_P8 > 1) { __syncthreads(); pg8::gemm_phase<EpiOut, pg8::StaticOrder, PG8_ALIGN, PG8_SP2>(ring, g, S, E); }
    }
    SEAM(8);
    if (IN(9)) { for (int i = 0; i < PROBE_SYNC; ++i) xcd_barrier(xbar);
                 phase_ln(a, lane, wave); }
#undef IN
#undef SEAM
}

extern "C" void kernel_launch(void* const* d_in, const int* in_sizes, int n_in, void* d_out, int out_size, void* d_ws, size_t ws_size, hipStream_t stream) {
    static int grid = 0;
    if (grid == 0) {
        if (n_in != 16 || out_size != MLAT * 2048 || ws_size < WS_END) { fprintf(stderr, "kernel_launch: unexpected shapes (n_in %d out %d ws %zu need %zu)\n", n_in, out_size, ws_size, (size_t)WS_END); grid = -1; return; }
        int dev = 0, cus = 0, per_cu = 0;
        hipGetDevice(&dev); hipDeviceGetAttribute(&cus, hipDeviceAttributeMultiprocessorCount, dev);
        if (hipFuncSetAttribute((const void*)mk_fwd, hipFuncAttributeMaxDynamicSharedMemorySize, LDS_BYTES) != hipSuccess) { fprintf(stderr, "kernel_launch: hipFuncSetAttribute failed\n"); grid = -1; return; }
        if (hipOccupancyMaxActiveBlocksPerMultiprocessor(&per_cu, (const void*)mk_fwd, 512, LDS_BYTES) != hipSuccess || per_cu < 1) { fprintf(stderr, "kernel_launch: occupancy query says %d\n", per_cu); per_cu = 1; }
        (void)hipGetLastError();
        grid = cus * 1;
    }
    if (grid < 0) return;
    (void)hipMemsetAsync((char*)d_ws + WS_MOD, 0, 163840, stream);
    Args a{};
    a.x = (const float*)d_in[0]; a.c = (const float*)d_in[1]; a.ctx = (const float*)d_in[2]; a.c_ctx = (const float*)d_in[3];
    a.w_mod = (const float*)d_in[4]; a.b_mod = (const float*)d_in[5]; a.w_in = (const float*)d_in[6]; a.na_rpb = (const float*)d_in[7];
    a.w_gate2 = (const float*)d_in[8]; a.b_gate = (const float*)d_in[9]; a.norm_g = (const float*)d_in[10]; a.w_br_a = (const float*)d_in[11];
    a.w_br_b = (const float*)d_in[12]; a.w_out = (const float*)d_in[13]; a.ln_g = (const float*)d_in[14]; a.ln_b = (const float*)d_in[15];
    a.out = (float*)d_out; a.ws = (unsigned char*)d_ws;
#if MK_MULTI
    for (int p = 0; p < NPHASE; ++p) { a.ph_lo = p; a.ph_hi = p + 1; hipLaunchKernelGGL(mk_fwd, dim3(grid), dim3(512), LDS_BYTES, stream, a); }
#else
    a.ph_lo = 0; a.ph_hi = NPHASE;
    void* args[] = {&a};
    hipError_t e = hipLaunchCooperativeKernel((const void*)mk_fwd, dim3(grid), dim3(512), args, LDS_BYTES, stream);
    if (e != hipSuccess) fprintf(stderr, "kernel_launch: cooperative launch failed: %s (grid %d)\n", hipGetErrorString(e), grid);
#endif
}
```

```cpp
#include <hip/hip_runtime.h>
#include <hip/hip_cooperative_groups.h>
#include <cstdio>
#include <cstdint>
namespace cg = cooperative_groups;

namespace pg8 {
#define PG8_LAS __attribute__((address_space(3)))
typedef unsigned short bf16_t;
typedef short bf16x8 __attribute__((ext_vector_type(8)));
typedef float f32x4 __attribute__((ext_vector_type(4)));
typedef unsigned u32x4 __attribute__((ext_vector_type(4)));
constexpr int BM = 256, BK = 64, HALF = 128, HTB = HALF * BK * 2  , STAGE_BYTES = 8 * HTB, NXCD = 8, WGM = 8;

__host__ __device__ __forceinline__ int lds_byte(int r, int c) { const int st = (r >> 4) * 2 + (c >> 5), rr = r & 15, cc = c & 31, ob = rr * 64 + cc * 2; return st * 1024 + (ob ^ (((ob >> 9) & 1) << 5)); }
__host__ __device__ __forceinline__ void stage_rc(int b, int& R, int& C) { const int st = b / 1024, sb = b % 1024, swz = sb ^ (((sb >> 9) & 1) << 5); R = (st >> 1) * 16 + swz / 64; C = (st & 1) * 32 + (swz % 64) / 2; }
__host__ __device__ __forceinline__ int perm32(int rho) { const int n = rho >> 4, i = rho & 15; return 8 * (i >> 2) + 4 * n + (i & 3); }

struct Unit { int pm, pn; };
struct Gemm { const bf16_t* A; const bf16_t* Bt; int M, N, K; };

struct StaticOrder {
    int nM, nN, nwg, G, c;
    __host__ __device__ void init(int M, int N, int G_, int c_) { nM = M / BM; nN = N / BM; nwg = nM * nN; G = G_; c = c_; }
    __host__ __device__ bool next(int i, Unit& u) const {
        const long L = (long)i * G + c; if (L >= nwg) return false;
        int wgid = (int)L; { const int q = nwg / NXCD, r = nwg % NXCD, xcd = wgid % NXCD, off = wgid / NXCD; wgid = (xcd < r ? xcd * (q + 1) : r * (q + 1) + (xcd - r) * q) + off; }
        const int nig = WGM * nN, gid = wgid / nig, fm = gid * WGM, gsz = (nM - fm) < WGM ? (nM - fm) : WGM;
        u.pm = fm + ((wgid % nig) % gsz); u.pn = (wgid % nig) / gsz; return true;
    }
    __device__ __forceinline__ void a_ready(const Unit&) const {}
    __device__ __forceinline__ void done(const Unit&) const {}
};

__device__ __forceinline__ unsigned cvt_pk_bf16(float lo, float hi) { unsigned r; asm volatile("v_cvt_pk_bf16_f32 %0, %1, %2" : "=v"(r) : "v"(lo), "v"(hi)); return r; }

template <class Epi, class Sched, bool ALIGN_EPI = false, bool SP2 = false>
__device__ __forceinline__ void gemm_phase(PG8_LAS unsigned char* lds, const Gemm g, const Sched& S, const Epi& E) {
    const int tid = threadIdx.x, wid = __builtin_amdgcn_readfirstlane(tid >> 6), lane = tid & 63, wr = wid >> 2, wc = wid & 3, fr = lane & 15, fq = lane >> 4;
    const int K = g.K, nt = K / BK;
    unsigned voffA[2], voffB[2];
#pragma unroll
    for (int i = 0; i < 2; ++i) { int R, C; stage_rc(tid * 16 + i * 8192, R, C); const int Rb = Epi::PERM ? ((R & ~31) + perm32(R & 31)) : R;
        voffA[i] = (unsigned)(R * K + C) * 2u; voffB[i] = (unsigned)(Rb * K + C) * 2u; }
    const size_t kstep = (size_t)(BK * 2);
    const size_t hstep = (size_t)HALF * K * 2;
    const size_t tstep = 2 * hstep;
    const unsigned ldsw = (unsigned)wid * 1024u;
    const int aoff = lds_byte(wr * 64 + fr, fq * 8), boff = lds_byte(wc * 32 + fr, fq * 8);
#define PG8_SA(b, h) (((b) * 2 + (h)) * HTB)
#define PG8_SB(b, h) ((4 + (b) * 2 + (h)) * HTB)
#define PG8_STAGE(bufoff, gbase, voff) do { _Pragma("unroll") for (int _i = 0; _i < 2; ++_i) \
        __builtin_amdgcn_global_load_lds((const unsigned*)((const char*)(gbase) + (voff)[_i]), (PG8_LAS unsigned*)(lds + (bufoff) + ldsw + _i * 8192), 16, 0, 0); } while (0)
#define PG8_LDA(dst, b, h) do { _Pragma("unroll") for (int m = 0; m < 4; ++m) _Pragma("unroll") for (int k = 0; k < 2; ++k) dst[m][k] = *(const PG8_LAS bf16x8*)(lds + PG8_SA(b, h) + aoff + m * 2048 + k * 1024); } while (0)
#define PG8_LDB(dst, b, h) do { _Pragma("unroll") for (int n = 0; n < 2; ++n) _Pragma("unroll") for (int k = 0; k < 2; ++k) dst[n][k] = *(const PG8_LAS bf16x8*)(lds + PG8_SB(b, h) + boff + n * 2048 + k * 1024); } while (0)
#define PG8_MMA(ai, bj, At, Bt) do { __builtin_amdgcn_s_setprio(1); _Pragma("unroll") for (int m = 0; m < 4; ++m) _Pragma("unroll") for (int n = 0; n < 2; ++n) _Pragma("unroll") for (int k = 0; k < 2; ++k) \
        acc[ai][bj][m][n] = __builtin_amdgcn_mfma_f32_16x16x32_bf16(Bt[n][k], At[m][k], acc[ai][bj][m][n], 0, 0, 0); __builtin_amdgcn_s_setprio(0); } while (0)
#define PG8_WAIT_V(n) asm volatile("s_waitcnt vmcnt(" #n ")" ::: "memory")
#define PG8_WAIT_L(n) asm volatile("s_waitcnt lgkmcnt(" #n ")" ::: "memory")
#define PG8_BAR __builtin_amdgcn_s_barrier()
#define PG8_SCHED __builtin_amdgcn_sched_barrier(0)
    Unit cur, nxt; int ui = 0;
    if (!S.next(0, cur)) return;
    f32x4 acc[2][2][4][2];
#pragma unroll
    for (int a = 0; a < 2; ++a)
#pragma unroll
        for (int b = 0; b < 2; ++b)
#pragma unroll
            for (int m = 0; m < 4; ++m)
#pragma unroll
                for (int n = 0; n < 2; ++n) acc[a][b][m][n] = (f32x4){0.f, 0.f, 0.f, 0.f};
    bf16x8 At[4][2], B0[2][2], B1[2][2];
    const char* cA = (const char*)g.A + (size_t)cur.pm * tstep; const char* cB = (const char*)g.Bt + (size_t)cur.pn * tstep;
    S.a_ready(cur);
    if constexpr (SP2) {
        PG8_STAGE(PG8_SB(0, 0), cB, voffB); PG8_STAGE(PG8_SB(0, 1), cB + hstep, voffB); PG8_STAGE(PG8_SA(0, 0), cA, voffA); PG8_STAGE(PG8_SA(0, 1), cA + hstep, voffA);
        if (wr == 1) PG8_BAR;
        PG8_WAIT_V(2); PG8_BAR;
        PG8_STAGE(PG8_SB(1, 0), cB + kstep, voffB); PG8_STAGE(PG8_SA(1, 0), cA + kstep, voffA); PG8_STAGE(PG8_SB(1, 1), cB + hstep + kstep, voffB);
        PG8_WAIT_V(6); PG8_BAR;
    } else {
        PG8_STAGE(PG8_SB(0, 0), cB, voffB); PG8_STAGE(PG8_SA(0, 0), cA, voffA); PG8_STAGE(PG8_SB(0, 1), cB + hstep, voffB); PG8_STAGE(PG8_SA(0, 1), cA + hstep, voffA);
        if (wr == 1) PG8_BAR;
        PG8_WAIT_V(4); PG8_BAR;
        PG8_STAGE(PG8_SB(1, 0), cB + kstep, voffB); PG8_STAGE(PG8_SA(1, 0), cA + kstep, voffA); PG8_STAGE(PG8_SB(1, 1), cB + hstep + kstep, voffB);
        PG8_WAIT_V(6); PG8_BAR;
    }
    for (;;) {
        const bool has_next = S.next(ui + 1, nxt);
        const char* nA = has_next ? (const char*)g.A + (size_t)nxt.pm * tstep : cA; const char* nB = has_next ? (const char*)g.Bt + (size_t)nxt.pn * tstep : cB;
        for (int t = 0; t < nt; t += 2) {
            const bool last = (t == nt - 2);
            const char* a1 = cA + (size_t)(t + 1) * kstep;
            const char* a2 = last ? nA : cA + (size_t)(t + 2) * kstep; const char* b2 = last ? nB : cB + (size_t)(t + 2) * kstep;
            const char* a3 = a2 + kstep; const char* b3 = b2 + kstep;
            if (last && has_next) S.a_ready(nxt);
            if constexpr (SP2) {
            PG8_LDB(B0, 0, 0); PG8_LDB(B1, 0, 1); PG8_SCHED; PG8_LDA(At, 0, 0); PG8_STAGE(PG8_SA(1, 1), a1 + hstep, voffA);
            PG8_WAIT_V(8); PG8_WAIT_L(0); PG8_BAR; PG8_MMA(0, 0, At, B0); PG8_MMA(0, 1, At, B1); PG8_BAR; PG8_SCHED;
            PG8_LDA(At, 0, 1); PG8_STAGE(PG8_SB(0, 0), b2, voffB); PG8_STAGE(PG8_SB(0, 1), b2 + hstep, voffB); PG8_STAGE(PG8_SA(0, 0), a2, voffA);
            PG8_WAIT_V(8); PG8_WAIT_L(0); PG8_BAR; PG8_MMA(1, 0, At, B0); PG8_MMA(1, 1, At, B1); PG8_BAR; PG8_SCHED;
            PG8_LDB(B0, 1, 0); PG8_LDB(B1, 1, 1); PG8_SCHED; PG8_LDA(At, 1, 0); PG8_STAGE(PG8_SA(0, 1), a2 + hstep, voffA);
            PG8_WAIT_V(8); PG8_WAIT_L(0); PG8_BAR; PG8_MMA(0, 0, At, B0); PG8_MMA(0, 1, At, B1); PG8_BAR; PG8_SCHED;
            PG8_LDA(At, 1, 1); PG8_STAGE(PG8_SB(1, 0), b3, voffB); PG8_STAGE(PG8_SB(1, 1), b3 + hstep, voffB); PG8_STAGE(PG8_SA(1, 0), a3, voffA);
            PG8_WAIT_V(8); PG8_WAIT_L(0); PG8_BAR; PG8_MMA(1, 0, At, B0); PG8_MMA(1, 1, At, B1); PG8_BAR; PG8_SCHED;
            } else {
            PG8_LDB(B0, 0, 0); PG8_SCHED; PG8_LDA(At, 0, 0); PG8_STAGE(PG8_SA(1, 1), a1 + hstep, voffA);
            PG8_WAIT_L(8); PG8_BAR; PG8_WAIT_L(0); PG8_MMA(0, 0, At, B0); PG8_BAR; PG8_SCHED;
            PG8_LDB(B1, 0, 1); PG8_STAGE(PG8_SB(0, 0), b2, voffB);
            PG8_BAR; PG8_WAIT_L(0); PG8_MMA(0, 1, At, B1); PG8_BAR;
            PG8_LDA(At, 0, 1); PG8_STAGE(PG8_SA(0, 0), a2, voffA);
            PG8_BAR; PG8_WAIT_L(0); PG8_MMA(1, 0, At, B0); PG8_BAR; PG8_SCHED;
            PG8_STAGE(PG8_SB(0, 1), b2 + hstep, voffB);
            PG8_WAIT_V(6); PG8_BAR; PG8_MMA(1, 1, At, B1); PG8_BAR;
            PG8_LDB(B0, 1, 0); PG8_SCHED; PG8_LDA(At, 1, 0); PG8_STAGE(PG8_SA(0, 1), a2 + hstep, voffA);
            PG8_WAIT_L(8); PG8_BAR; PG8_WAIT_L(0); PG8_MMA(0, 0, At, B0); PG8_BAR; PG8_SCHED;
            PG8_LDB(B1, 1, 1); PG8_STAGE(PG8_SB(1, 0), b3, voffB);
            PG8_BAR; PG8_WAIT_L(0); PG8_MMA(0, 1, At, B1); PG8_BAR;
            PG8_LDA(At, 1, 1); PG8_STAGE(PG8_SA(1, 0), a3, voffA);
            PG8_BAR; PG8_WAIT_L(0); PG8_MMA(1, 0, At, B0); PG8_BAR; PG8_SCHED;
            PG8_STAGE(PG8_SB(1, 1), b3 + hstep, voffB);
            PG8_WAIT_V(6); PG8_BAR; PG8_MMA(1, 1, At, B1); PG8_BAR;
            }
        }
        if constexpr (ALIGN_EPI) { if (wr == 0) PG8_BAR; }
        if constexpr (!Epi::AFTER_DRAIN) { E(acc, cur, wr, wc, fr, fq); S.done(cur); }
        if (!has_next) break;
#pragma unroll
        for (int a = 0; a < 2; ++a)
#pragma unroll
            for (int b = 0; b < 2; ++b)
#pragma unroll
                for (int m = 0; m < 4; ++m)
#pragma unroll
                    for (int n = 0; n < 2; ++n) acc[a][b][m][n] = (f32x4){0.f, 0.f, 0.f, 0.f};
        cur = nxt; cA = nA; cB = nB; ++ui;
        if constexpr (ALIGN_EPI) { if (wr == 1) PG8_BAR; }
    }
    PG8_WAIT_V(0);
    if constexpr (!ALIGN_EPI) { if (wr == 0) PG8_BAR; }
    PG8_BAR;
    if constexpr (Epi::AFTER_DRAIN) { E.fused(acc, cur, wr, wc, fr, fq, lds, wid, lane); S.done(cur); }
#undef PG8_SA
#undef PG8_SB
#undef PG8_STAGE
#undef PG8_LDA
#undef PG8_LDB
#undef PG8_MMA
#undef PG8_WAIT_V
#undef PG8_WAIT_L
#undef PG8_BAR
#undef PG8_SCHED
}
}

#ifndef PG8_SP2
#define PG8_SP2 true
#endif
#ifndef PG8_ALIGN
#define PG8_ALIGN true
#endif
#ifndef PROBE_P2
#define PROBE_P2 1
#endif
#ifndef PROBE_P3D
#define PROBE_P3D 0
#endif
#ifndef PROBE_P4D
#define PROBE_P4D 0
#endif
#ifndef PROBE_P5
#define PROBE_P5 1
#endif
#ifndef SCOUT
#define SCOUT 3
#endif
#ifndef PROBE_P8
#define PROBE_P8 1
#endif
#ifndef PROBE_P1
#define PROBE_P1 1
#endif
#ifndef PROBE_RED
#define PROBE_RED 0
#endif
#ifndef PROBE_SYNC
#define PROBE_SYNC 0
#endif
#ifndef MK_MULTI
#define MK_MULTI 0
#endif

constexpr int DM = 2048, SEQ = 16384, MLAT = 32768, MCTX = 512, MR = 33280;
constexpr int NPROJ = 14592;
constexpr int NPHASE = 10;
typedef unsigned short bf16_t;
typedef short bf16x8 __attribute__((ext_vector_type(8)));
typedef float f32x4 __attribute__((ext_vector_type(4)));
typedef float f32x16 __attribute__((ext_vector_type(16)));
typedef unsigned u32x4 __attribute__((ext_vector_type(4)));
typedef unsigned u32x2 __attribute__((ext_vector_type(2)));
typedef float f32x2 __attribute__((ext_vector_type(2)));

constexpr size_t SZ1 = (size_t)MR * 1024 * 2, SZ2 = (size_t)MR * 2048 * 2;
constexpr size_t WS_MOD = 0;
constexpr size_t WS_XBAR = 131072;
constexpr size_t WS_AQ = 1u << 20;
constexpr size_t WS_AK = WS_AQ + SZ1;
constexpr size_t WS_AVT = WS_AK + SZ1;
constexpr size_t WS_AZ = WS_AVT + SZ1;
constexpr size_t WS_BQ = WS_AZ + SZ1;
constexpr size_t WS_BK = WS_BQ + SZ1;
constexpr size_t WS_BVT = WS_BK + SZ1;
constexpr size_t WS_BZ = WS_BVT + SZ2;
constexpr size_t WS_MGA = WS_BZ + SZ2;
constexpr size_t WS_MGB = WS_MGA + SZ2;
constexpr size_t WS_BG = WS_MGB + SZ2;
constexpr size_t WS_WA = WS_BG + (size_t)MR * 32 * 4;
constexpr size_t WS_WB = WS_WA + (size_t)2048 * 1024 * 2;
constexpr size_t WS_WO = WS_WB + (size_t)2048 * 2048 * 2;
constexpr size_t WS_ATT = WS_WO + (size_t)2048 * 2048 * 2;
constexpr size_t WS_DL = WS_ATT + (size_t)2 * MLAT * 256 * 2;
constexpr size_t WS_END = WS_DL + (size_t)2 * 520 * 1024 * 4;
static_assert(WS_END <= (size_t)1073741824, "workspace map exceeds 1 GiB");
constexpr size_t DO_H = 0, DO_WIN = SZ2, DO_OF = 0, DO_OB = (size_t)MLAT * 2048 * 2;
static_assert(DO_WIN + (size_t)NPROJ * 2048 * 2 <= (size_t)MLAT * 2048 * 4, "d_out scratch");

constexpr int LDS_BYTES = 147456;

struct Args {
    const float *x, *c, *ctx, *c_ctx, *w_mod, *b_mod, *w_in, *na_rpb, *w_gate2, *b_gate, *norm_g, *w_br_a, *w_br_b, *w_out, *ln_g, *ln_b;
    float* out; unsigned char* ws; int ph_lo, ph_hi;
};

typedef __bf16 bf16x2_t __attribute__((ext_vector_type(2)));
__device__ __forceinline__ unsigned pk2(float lo, float hi) { const f32x2 v = {lo, hi}; const bf16x2_t b = __builtin_convertvector(v, bf16x2_t); return __builtin_bit_cast(unsigned, b); }
typedef _Float16 f16x2_t __attribute__((ext_vector_type(2)));
__device__ __forceinline__ unsigned pkh2(float lo, float hi) { const f32x2 v = {lo, hi}; const f16x2_t h = __builtin_convertvector(v, f16x2_t); return __builtin_bit_cast(unsigned, h); }
__device__ __forceinline__ f32x2 unpkh2(unsigned u) { return __builtin_convertvector(__builtin_bit_cast(f16x2_t, u), f32x2); }
__device__ __forceinline__ float bflo(unsigned u) { return __builtin_bit_cast(float, u << 16); }
__device__ __forceinline__ float bfhi(unsigned u) { return __builtin_bit_cast(float, u & 0xffff0000u); }
__device__ __forceinline__ float silu_f(float v) { return v * __builtin_amdgcn_rcpf(1.f + __expf(-v)); }
__device__ __forceinline__ float sigmoid_f(float v) { return __builtin_amdgcn_rcpf(1.f + __expf(-v)); }
__device__ __forceinline__ float wave_sum(float v) {
#pragma unroll
    for (int o = 1; o < 64; o <<= 1) v += __shfl_xor(v, o);
    return v;
}
__device__ __forceinline__ f32x4 mfma16(bf16x8 a, bf16x8 b, f32x4 c) { return __builtin_amdgcn_mfma_f32_16x16x32_bf16(a, b, c, 0, 0, 0); }
__device__ __forceinline__ f32x16 mfma32(bf16x8 a, bf16x8 b, f32x16 c) { return __builtin_amdgcn_mfma_f32_32x32x16_bf16(a, b, c, 0, 0, 0); }

__device__ __forceinline__ void transpose_item(const float* W, int ldw, int K, bf16_t* WT, int k0, int n0, int drow0, float* scr, int lane) {
#pragma unroll 8
    for (int i = 0; i < 32; ++i) { const int kk = 2 * i + (lane >> 5); scr[kk * 33 + (lane & 31)] = W[(size_t)(k0 + kk) * ldw + n0 + (lane & 31)]; }
    asm volatile("s_waitcnt lgkmcnt(0)" ::: "memory");
    const int c = lane & 7;
#pragma unroll
    for (int j = 0; j < 4; ++j) { const int n = (lane >> 3) + 8 * j; const float* s = scr + (8 * c) * 33 + n;
        u32x4 o; o.x = pk2(s[0 * 33], s[1 * 33]); o.y = pk2(s[2 * 33], s[3 * 33]); o.z = pk2(s[4 * 33], s[5 * 33]); o.w = pk2(s[6 * 33], s[7 * 33]);
        *(u32x4*)(WT + (size_t)(drow0 + n) * K + k0 + 8 * c) = o; }
    asm volatile("s_waitcnt lgkmcnt(0)" ::: "memory");
}

__device__ __forceinline__ void phase0(const Args& a, unsigned char* smem, int tid, int lane, int wave) {
    const int gw = blockIdx.x * 8 + wave, NGW = gridDim.x * 8;
    float* sv = (float*)(smem + 69632);
    for (int i = tid; i < 3 * 2048; i += 512) { const int j = i >> 11, k = i & 2047; const float v = (j < 2) ? a.c[j * 2048 + k] : a.c_ctx[k]; sv[i] = silu_f(v); }
    __syncthreads();
    float* MOD = (float*)(a.ws + WS_MOD);
    for (int it = gw; it < 1536; it += NGW) {
        const int ks = it / 24, cb = it % 24, k0 = ks * 32;
        const float* wp = a.w_mod + (size_t)k0 * 6144 + cb * 256 + lane * 4;
        f32x4 a0 = {0.f, 0.f, 0.f, 0.f}, a1 = a0, a2 = a0;
#pragma unroll 8
        for (int kk = 0; kk < 32; ++kk) { const f32x4 w = *(const f32x4*)(wp + (size_t)kk * 6144);
            a0 += w * sv[k0 + kk]; a1 += w * sv[2048 + k0 + kk]; a2 += w * sv[4096 + k0 + kk]; }
        float* mo = MOD + cb * 256 + lane * 4;
#pragma unroll
        for (int e = 0; e < 4; ++e) { __hip_atomic_fetch_add(mo + e, a0[e], __ATOMIC_RELAXED, __HIP_MEMORY_SCOPE_AGENT);
            __hip_atomic_fetch_add(mo + 6144 + e, a1[e], __ATOMIC_RELAXED, __HIP_MEMORY_SCOPE_AGENT);
            __hip_atomic_fetch_add(mo + 12288 + e, a2[e], __ATOMIC_RELAXED, __HIP_MEMORY_SCOPE_AGENT); }
    }
    float* scr = (float*)(smem + wave * 8448);
    bf16_t* WinT = (bf16_t*)((unsigned char*)a.out + DO_WIN);
    constexpr int I_IN = 32 * 449, I_A = 16 * 64, I_B = 32 * 64, I_O = 32 * 64;
    for (int it = gw; it < I_IN + I_A + I_B + I_O; it += NGW) {
        int r = it;
        if (r < I_IN) { const int kb = r / 449, nb = r % 449, n0 = nb * 32;
            const int drow = n0 < 10240 ? n0 : (n0 < 10272 ? 14336 + (n0 - 10240) : n0 - 32);
            transpose_item(a.w_in, 14368, 2048, WinT, kb * 64, n0, drow, scr, lane); continue; }
        r -= I_IN;
        if (r < I_A) { transpose_item(a.w_br_a, 2048, 1024, (bf16_t*)(a.ws + WS_WA), (r >> 6) * 64, (r & 63) * 32, (r & 63) * 32, scr, lane); continue; }
        r -= I_A;
        if (r < I_B) { transpose_item(a.w_br_b, 2048, 2048, (bf16_t*)(a.ws + WS_WB), (r >> 6) * 64, (r & 63) * 32, (r & 63) * 32, scr, lane); continue; }
        r -= I_B;
        transpose_item(a.w_out, 2048, 2048, (bf16_t*)(a.ws + WS_WO), (r >> 6) * 64, (r & 63) * 32, (r & 63) * 32, scr, lane);
    }
    { u32x4* z = (u32x4*)(WinT + (size_t)14368 * 2048); const u32x4 zero = {0u, 0u, 0u, 0u};
      for (int i = blockIdx.x * 512 + tid; i < 224 * 256; i += gridDim.x * 512) z[i] = zero; }
}

__device__ __forceinline__ void phase1(const Args& a, unsigned char* smem, int tid, int lane, int wave) {
    const int gw = blockIdx.x * 8 + wave, NGW = gridDim.x * 8;
    float* ss = (float*)smem;
    const float* MOD = (const float*)(a.ws + WS_MOD);
    for (int i = tid; i < 3 * 2048; i += 512) { const int j = i >> 11, k = i & 2047;
        ss[(j * 2 + 0) * 2048 + k] = 1.f + MOD[j * 6144 + 2048 + k] + a.b_mod[2048 + k];
        ss[(j * 2 + 1) * 2048 + k] = MOD[j * 6144 + k] + a.b_mod[k]; }
    __syncthreads();
    bf16_t* H = (bf16_t*)((unsigned char*)a.out + DO_H);
    for (int r = gw; r < MR; r += NGW) {
        const float* src = r < MLAT ? a.x + (size_t)r * 2048 : a.ctx + (size_t)(r - MLAT) * 2048;
        const int j = r < MLAT ? (r >> 14) : 2;
        const f32x4* xr = (const f32x4*)src + lane;
        f32x4 v[8]; float s = 0.f;
#pragma unroll
        for (int q = 0; q < 8; ++q) { v[q] = __builtin_nontemporal_load(xr + 64 * q); s += (v[q].x + v[q].y) + (v[q].z + v[q].w); }
        const float mean = wave_sum(s) * (1.f / 2048.f); float s2 = 0.f;
#pragma unroll
        for (int q = 0; q < 8; ++q) { v[q] = v[q] - mean; s2 += (v[q].x * v[q].x + v[q].y * v[q].y) + (v[q].z * v[q].z + v[q].w * v[q].w); }
        const float rstd = rsqrtf(wave_sum(s2) * (1.f / 2048.f) + 1e-6f);
        u32x2* o8 = (u32x2*)(H + (size_t)r * 2048) + lane;
        const f32x4* sc = (const f32x4*)(ss + (j * 2 + 0) * 2048) + lane; const f32x4* sh = (const f32x4*)(ss + (j * 2 + 1) * 2048) + lane;
#pragma unroll
        for (int q = 0; q < 8; ++q) { const f32x4 y = v[q] * rstd * sc[64 * q] + sh[64 * q]; u32x2 o; o.x = pk2(y.x, y.y); o.y = pk2(y.z, y.w); o8[64 * q] = o; }
    }
}

struct EpiProj {
    static constexpr bool PERM = true, AFTER_DRAIN = false;
    unsigned char* ws; unsigned char* lds_epi;
    __device__ __forceinline__ void operator()(const f32x4 (&acc)[2][2][4][2], const pg8::Unit& u, int wr, int wc, int fr, int fq) const {
        const int pn = u.pn, row0 = u.pm * 256 + wr * 64 + fr;
        if (pn == 56) {
            if (wc == 0) { float* BG = (float*)(ws + WS_BG);
#pragma unroll
                for (int ai = 0; ai < 2; ++ai)
#pragma unroll
                    for (int m = 0; m < 4; ++m) { float* p = BG + (size_t)(row0 + ai * 128 + m * 16) * 32 + 8 * fq;
                        *(f32x4*)p = acc[ai][0][m][0]; *(f32x4*)(p + 4) = acc[ai][0][m][1]; } }
            return;
        }
        const bool tr = (pn >= 8 && pn < 12) || (pn >= 24 && pn < 32);
        unsigned char* base; int colt, ld;
        if (pn < 24) { base = ws + WS_AQ + (size_t)(pn >> 2) * SZ1; colt = (pn & 3) * 256; ld = 1024; }
        else { base = ws + WS_BVT + (size_t)((pn - 24) >> 3) * SZ2; colt = ((pn - 24) & 7) * 256; ld = 2048; }
        if (tr) {
            bf16_t* VO = (bf16_t*)base; const bool isb = pn >= 24;
            bf16_t* T = (bf16_t*)(lds_epi + (wr * 4 + wc) * 2048);
            const int lane = fq * 16 + fr, col = lane & 31, half = lane >> 5;
#pragma unroll
            for (int ai = 0; ai < 2; ++ai)
#pragma unroll
                for (int m = 0; m < 4; ++m)
#pragma unroll
                    for (int bj = 0; bj < 2; ++bj) {
#pragma unroll
                        for (int n = 0; n < 2; ++n) { const f32x4 v = acc[ai][bj][m][n]; const unsigned w0 = pk2(v[0], v[1]), w1 = pk2(v[2], v[3]);
                            bf16_t* p = T + (8 * fq + 4 * n) * 24 + fr;
                            p[0] = (bf16_t)(w0 & 0xffffu); p[24] = (bf16_t)(w0 >> 16); p[48] = (bf16_t)(w1 & 0xffffu); p[72] = (bf16_t)(w1 >> 16); }
                        asm volatile("s_waitcnt lgkmcnt(0)" ::: "memory");
                        const u32x4 w = *(const u32x4*)(T + col * 24 + half * 8);
                        asm volatile("s_waitcnt lgkmcnt(0)" ::: "memory");
                        const int dvg = colt + bj * 128 + wc * 32 + col;
                        if (isb) { const size_t gc = (size_t)u.pm * 4 + ai * 2 + wr;
                            *(u32x4*)(VO + ((((gc * 4 + (dvg >> 9)) * 16 + ((dvg >> 5) & 15)) * 4 + m) * 64 + half * 32 + col) * 8) = w; }
                        else *(u32x4*)(VO + (size_t)dvg * MR + (size_t)(u.pm * 256 + ai * 128 + wr * 64 + m * 16 + half * 8)) = w;
                    }
        } else {
            bf16_t* O = (bf16_t*)base; const int col0 = colt + wc * 32 + 8 * fq;
#pragma unroll
            for (int ai = 0; ai < 2; ++ai)
#pragma unroll
                for (int m = 0; m < 4; ++m) { bf16_t* rowp = O + (size_t)(row0 + ai * 128 + m * 16) * ld + col0;
#pragma unroll
                    for (int bj = 0; bj < 2; ++bj) { const f32x4 v0 = acc[ai][bj][m][0], v1 = acc[ai][bj][m][1];
                        u32x4 w; w.x = pk2(v0[0], v0[1]); w.y = pk2(v0[2], v0[3]); w.z = pk2(v1[0], v1[1]); w.w = pk2(v1[2], v1[3]);
                        *(u32x4*)(rowp + bj * 128) = w; } }
        }
    }
};

struct EpiMerge1 {
    static constexpr bool PERM = true, AFTER_DRAIN = false;
    bf16_t* G;
    __device__ __forceinline__ void operator()(const f32x4 (&acc)[2][2][4][2], const pg8::Unit& u, int wr, int wc, int fr, int fq) const {
        const int row0 = u.pm * 256 + wr * 64 + fr, col0 = u.pn * 256 + wc * 32 + 8 * fq;
#pragma unroll
        for (int ai = 0; ai < 2; ++ai) {
            u32x4 gb[4][2];
#pragma unroll
            for (int m = 0; m < 4; ++m)
#pragma unroll
                for (int bj = 0; bj < 2; ++bj) gb[m][bj] = __builtin_nontemporal_load((const u32x4*)(G + (size_t)(row0 + ai * 128 + m * 16) * 2048 + col0 + bj * 128));
            asm volatile("" ::: "memory");
#pragma unroll
            for (int m = 0; m < 4; ++m) { bf16_t* rowp = G + (size_t)(row0 + ai * 128 + m * 16) * 2048 + col0;
#pragma unroll
                for (int bj = 0; bj < 2; ++bj) { const u32x4 g = gb[m][bj]; const f32x4 v0 = acc[ai][bj][m][0], v1 = acc[ai][bj][m][1];
                    u32x4 w; w.x = pk2(sigmoid_f(bflo(g.x)) * v0[0], sigmoid_f(bfhi(g.x)) * v0[1]); w.y = pk2(sigmoid_f(bflo(g.y)) * v0[2], sigmoid_f(bfhi(g.y)) * v0[3]);
                    w.z = pk2(sigmoid_f(bflo(g.z)) * v1[0], sigmoid_f(bfhi(g.z)) * v1[1]); w.w = pk2(sigmoid_f(bflo(g.w)) * v1[2], sigmoid_f(bfhi(g.w)) * v1[3]);
                    *(u32x4*)(rowp + bj * 128) = w; } }
        }
    }
};
struct EpiMerge2 {
    static constexpr bool PERM = true, AFTER_DRAIN = false;
    const bf16_t* T; const bf16_t* G; bf16_t* O;
    __device__ __forceinline__ void operator()(const f32x4 (&acc)[2][2][4][2], const pg8::Unit& u, int wr, int wc, int fr, int fq) const {
        const int row0 = u.pm * 256 + wr * 64 + fr, col0 = u.pn * 256 + wc * 32 + 8 * fq;
#pragma unroll
        for (int ai = 0; ai < 2; ++ai)
#pragma unroll
          for (int mp = 0; mp < 2; ++mp) {
            u32x4 gb[2][2], tb[2][2];
#pragma unroll
            for (int mm = 0; mm < 2; ++mm)
#pragma unroll
                for (int bj = 0; bj < 2; ++bj) { const size_t ro = (size_t)(row0 + ai * 128 + (mp * 2 + mm) * 16) * 2048 + col0 + bj * 128; gb[mm][bj] = __builtin_nontemporal_load((const u32x4*)(G + ro)); tb[mm][bj] = __builtin_nontemporal_load((const u32x4*)(T + ro)); }
            asm volatile("" ::: "memory");
#pragma unroll
            for (int mm = 0; mm < 2; ++mm) { const int m = mp * 2 + mm; const size_t ro = (size_t)(row0 + ai * 128 + m * 16) * 2048 + col0;
#pragma unroll
                for (int bj = 0; bj < 2; ++bj) { const u32x4 g = gb[mm][bj]; const u32x4 t = tb[mm][bj];
                    const f32x4 v0 = acc[ai][bj][m][0], v1 = acc[ai][bj][m][1];
                    u32x4 w; w.x = pk2(bflo(t.x) + sigmoid_f(bflo(g.x)) * v0[0], bfhi(t.x) + sigmoid_f(bfhi(g.x)) * v0[1]);
                    w.y = pk2(bflo(t.y) + sigmoid_f(bflo(g.y)) * v0[2], bfhi(t.y) + sigmoid_f(bfhi(g.y)) * v0[3]);
                    w.z = pk2(bflo(t.z) + sigmoid_f(bflo(g.z)) * v1[0], bfhi(t.z) + sigmoid_f(bfhi(g.z)) * v1[1]);
                    w.w = pk2(bflo(t.w) + sigmoid_f(bflo(g.w)) * v1[2], bfhi(t.w) + sigmoid_f(bfhi(g.w)) * v1[3]);
                    *(u32x4*)(O + ro + bj * 128) = w; } }
          }
    }
};
struct EpiOut {
    static constexpr bool PERM = true, AFTER_DRAIN = false;
    const float* x; const float* MOD; const float* b_mod; bf16_t* out;
    __device__ __forceinline__ void operator()(const f32x4 (&acc)[2][2][4][2], const pg8::Unit& u, int wr, int wc, int fr, int fq) const {
        const int row0 = u.pm * 256 + wr * 64 + fr, col0 = u.pn * 256 + wc * 32 + 8 * fq;
        const int b = (u.pm * 256) >> 14;
        f32x4 gt[2][2];
#pragma unroll
        for (int bj = 0; bj < 2; ++bj)
#pragma unroll
            for (int n = 0; n < 2; ++n) gt[bj][n] = *(const f32x4*)(MOD + b * 6144 + 4096 + col0 + bj * 128 + 4 * n) + *(const f32x4*)(b_mod + 4096 + col0 + bj * 128 + 4 * n);
#pragma unroll
        for (int ai = 0; ai < 2; ++ai)
#pragma unroll
          for (int mp = 0; mp < 2; ++mp) {
            f32x4 xb[2][2][2];
#pragma unroll
            for (int mm = 0; mm < 2; ++mm)
#pragma unroll
                for (int bj = 0; bj < 2; ++bj)
#pragma unroll
                    for (int n = 0; n < 2; ++n) xb[mm][bj][n] = __builtin_nontemporal_load((const f32x4*)(x + (size_t)(row0 + ai * 128 + (mp * 2 + mm) * 16) * 2048 + col0 + bj * 128 + 4 * n));
            asm volatile("" ::: "memory");
#pragma unroll
            for (int mm = 0; mm < 2; ++mm) { const int m = mp * 2 + mm; const size_t ro = (size_t)(row0 + ai * 128 + m * 16) * 2048 + col0;
#pragma unroll
                for (int bj = 0; bj < 2; ++bj) {
                    const f32x4 v0 = xb[mm][bj][0] * 1.189207115002721f + gt[bj][0] * acc[ai][bj][m][0], v1 = xb[mm][bj][1] * 1.189207115002721f + gt[bj][1] * acc[ai][bj][m][1];
                    u32x4 w; w.x = pkh2(v0[0], v0[1]); w.y = pkh2(v0[2], v0[3]); w.z = pkh2(v1[0], v1[1]); w.w = pkh2(v1[2], v1[3]);
                    *(u32x4*)(out + ro + bj * 128) = w; } }
          }
    }
};

__device__ __forceinline__ void phase_attn(const Args& a, unsigned char* smem, int tid, int lane, int wave, bf16_t* Yout) {
    bf16_t* Ks = (bf16_t*)smem;
    bf16_t* Vs = (bf16_t*)(smem + 36864);
    float* rpb_s = (float*)(smem + 70656);
    const bf16_t* AQ = (const bf16_t*)(a.ws + WS_AQ); const bf16_t* AK = (const bf16_t*)(a.ws + WS_AK);
    const bf16_t* AVT = (const bf16_t*)(a.ws + WS_AVT); const bf16_t* AZ = (const bf16_t*)(a.ws + WS_AZ);
    const int q16 = lane & 15, g = lane >> 4, wo = 8 * (q16 >> 2) + (q16 & 3);
    for (int bu = blockIdx.x; bu < 256; bu += gridDim.x) {
        const int combo = bu >> 3, b = combo >> 4, h = combo & 15, rbase = (bu & 7) * 32;
        __syncthreads();
#pragma unroll
        for (int j = 0; j < 4; ++j) { const int c = tid + 512 * j;
            { const int key = c >> 3, ch = c & 7; *(u32x4*)(Ks + key * 72 + ch * 8) = *(const u32x4*)(AK + (size_t)(MLAT + b * 256 + key) * 1024 + h * 64 + ch * 8); }
            { const int d = c >> 5, ch = c & 31; *(u32x4*)(Vs + d * 264 + ch * 8) = *(const u32x4*)(AVT + (size_t)(h * 64 + d) * MR + MLAT + b * 256 + ch * 8); } }
        if (tid < 465) rpb_s[tid] = a.na_rpb[h * 465 + tid];
        __syncthreads();
        for (int u = wave; u < 128; u += 8) {
            const int r = rbase + (u >> 2), qt = u & 3;
            const int c0 = qt * 16, kc0 = min(max(c0 - 8, 0), 32), rs = min(max(r - 4, 0), 248);
            const int qc = c0 + q16, cs = min(max(qc - 8, 0), 48);
            const size_t qrow = (size_t)b * 16384 + r * 64 + qc;
            const bf16x8 qf0 = *(const bf16x8*)(AQ + qrow * 1024 + h * 64 + 8 * g), qf1 = *(const bf16x8*)(AQ + qrow * 1024 + h * 64 + 32 + 8 * g);
            f32x4 st[32];
            bf16x8 kbuf[1][8];
#define ATT_KLOAD(bt, dstb) do { _Pragma("unroll") for (int ii_ = 0; ii_ < 2; ++ii_) _Pragma("unroll") for (int hf_ = 0; hf_ < 2; ++hf_) { \
                const size_t krow_ = (size_t)b * 16384 + (rs + (bt) * 2 + ii_) * 64 + kc0 + wo + 4 * hf_; \
                const bf16_t* kp_ = AK + krow_ * 1024 + h * 64 + 8 * g; \
                kbuf[dstb][(ii_ * 2 + hf_) * 2] = *(const bf16x8*)kp_; kbuf[dstb][(ii_ * 2 + hf_) * 2 + 1] = *(const bf16x8*)(kp_ + 32); } } while (0)
#pragma unroll
            for (int bt = 0; bt < 4; ++bt) {
                ATT_KLOAD(bt, 0);
                asm volatile("" ::: "memory");
#pragma unroll
                for (int ii = 0; ii < 2; ++ii) {
                    const int i = bt * 2 + ii;
                    const float* rp = rpb_s + (rs + i - r + 7) * 31;
#pragma unroll
                    for (int hf = 0; hf < 2; ++hf) {
                        f32x4 s = {0.f, 0.f, 0.f, 0.f};
                        s = mfma16(kbuf[0][(ii * 2 + hf) * 2], qf0, s); s = mfma16(kbuf[0][(ii * 2 + hf) * 2 + 1], qf1, s);
#pragma unroll
                        for (int e = 0; e < 4; ++e) { const int kc = kc0 + 8 * g + 4 * hf + e; const bool ok = (kc >= cs) && (kc < cs + 16);
                            const int dc = min(max(kc - qc + 15, 0), 30);
                            s[e] = ok ? s[e] * 0.125f + rp[dc] : -1e30f; }
                        st[i * 2 + hf] = s;
                    }
                }
            }
#undef ATT_KLOAD
            bf16x8 vbuf[1][8];
#define ATT_VLOAD(bt, dstb) do { _Pragma("unroll") for (int pp_ = 0; pp_ < 2; ++pp_) { \
                const size_t tokb_ = (size_t)b * 16384 + (rs + (bt) * 2 + pp_) * 64 + kc0 + 8 * g; \
                _Pragma("unroll") for (int mt_ = 0; mt_ < 4; ++mt_) vbuf[dstb][pp_ * 4 + mt_] = *(const bf16x8*)(AVT + (size_t)(h * 64 + mt_ * 16 + q16) * MR + tokb_); } } while (0)
#pragma unroll
            for (int c = 0; c < 8; ++c)
#pragma unroll
                for (int hf = 0; hf < 2; ++hf) {
                    const bf16_t* kp = Ks + (c * 32 + wo + 4 * hf) * 72 + 8 * g;
                    const bf16x8 k0 = *(const bf16x8*)kp, k1 = *(const bf16x8*)(kp + 32);
                    f32x4 s = {0.f, 0.f, 0.f, 0.f};
                    s = mfma16(k0, qf0, s); s = mfma16(k1, qf1, s);
                    st[16 + c * 2 + hf] = s * 0.125f;
                }
            float mx = -1e30f;
#pragma unroll
            for (int t = 0; t < 32; ++t) mx = fmaxf(fmaxf(fmaxf(st[t][0], st[t][1]), fmaxf(st[t][2], st[t][3])), mx);
            mx = fmaxf(mx, __shfl_xor(mx, 16)); mx = fmaxf(mx, __shfl_xor(mx, 32));
            float l = 0.f;
#pragma unroll
            for (int t = 0; t < 32; ++t) {
#pragma unroll
                for (int e = 0; e < 4; ++e) { const float p = __expf(st[t][e] - mx); st[t][e] = p; l += p; } }
            l += __shfl_xor(l, 16); l += __shfl_xor(l, 32);
            bf16x8 pb[16];
#pragma unroll
            for (int p = 0; p < 16; ++p) { u32x4 pw; pw.x = pk2(st[2 * p][0], st[2 * p][1]); pw.y = pk2(st[2 * p][2], st[2 * p][3]); pw.z = pk2(st[2 * p + 1][0], st[2 * p + 1][1]); pw.w = pk2(st[2 * p + 1][2], st[2 * p + 1][3]);
                pb[p] = __builtin_bit_cast(bf16x8, pw); }
            f32x4 o[4];
#pragma unroll
            for (int mt = 0; mt < 4; ++mt) o[mt] = (f32x4){0.f, 0.f, 0.f, 0.f};
            bf16x8 vb2[1][16];
#define ATT_VLOAD16(bt, dstb) do { _Pragma("unroll") for (int pp_ = 0; pp_ < 4; ++pp_) { \
                const size_t tokb_ = (size_t)b * 16384 + (rs + (bt) * 4 + pp_) * 64 + kc0 + 8 * g; \
                _Pragma("unroll") for (int mt_ = 0; mt_ < 4; ++mt_) vb2[dstb][pp_ * 4 + mt_] = *(const bf16x8*)(AVT + (size_t)(h * 64 + mt_ * 16 + q16) * MR + tokb_); } } while (0)
            ATT_VLOAD16(0, 0);
            asm volatile("" ::: "memory");
#pragma unroll
            for (int p = 8; p < 16; ++p) {
#pragma unroll
                for (int mt = 0; mt < 4; ++mt) o[mt] = mfma16(*(const bf16x8*)(Vs + (mt * 16 + q16) * 264 + (p - 8) * 32 + 8 * g), pb[p], o[mt]);
            }
            asm volatile("" ::: "memory");
#pragma unroll
            for (int bt = 0; bt < 2; ++bt) {
                if (bt == 1) { ATT_VLOAD16(1, 0); asm volatile("" ::: "memory"); }
#pragma unroll
                for (int pp = 0; pp < 4; ++pp)
#pragma unroll
                    for (int mt = 0; mt < 4; ++mt) o[mt] = mfma16(vb2[0][pp * 4 + mt], pb[bt * 4 + pp], o[mt]);
            }
#undef ATT_VLOAD16
#undef ATT_VLOAD
            const float inv = 1.f / l;
#pragma unroll
            for (int mt = 0; mt < 4; ++mt) {
                const size_t off = qrow * 1024 + h * 64 + mt * 16 + 4 * g;
                const u32x2 z = *(const u32x2*)(AZ + off);
                u32x2 w; w.x = pk2(o[mt][0] * inv * silu_f(bflo(z.x)), o[mt][1] * inv * silu_f(bfhi(z.x)));
                w.y = pk2(o[mt][2] * inv * silu_f(bflo(z.y)), o[mt][3] * inv * silu_f(bfhi(z.y)));
                *(u32x2*)(Yout + off) = w;
            }
        }
    }
}

__device__ __forceinline__ void phase_g0(const Args& a, unsigned char* smem, int tid, int lane, int wave, bf16_t* QEFdst) {
    float* lr = (float*)smem;
    float* w2s = (float*)(smem + 4096);
    float* bs = (float*)(smem + 12288);
    float* lastv = (float*)(smem + 12800);
    float* G = (float*)(smem + 16384);
    bf16_t* KDs = (bf16_t*)(smem + 16384);
    bf16_t* QEs = (bf16_t*)(smem + 49152);
    bf16_t* KEs = (bf16_t*)(smem + 82944);
    const bf16_t* BQ = (const bf16_t*)(a.ws + WS_BQ); const bf16_t* BK = (const bf16_t*)(a.ws + WS_BK);
    const float* BG = (const float*)(a.ws + WS_BG);
    bf16_t* ATT = (bf16_t*)(a.ws + WS_ATT); float* DL = (float*)(a.ws + WS_DL);
    const int q16 = lane & 15, g = lane >> 4;
    for (int u = blockIdx.x; u < 2080; u += gridDim.x) {
        const int gc = u >> 2, h = u & 3, row0 = gc * 64; const bool is_lat = gc < 512; const int n_l = gc & 255;
        float qr[2][16], kr[2][16];
#pragma unroll
        for (int it = 0; it < 2; ++it) {
            const int item = tid + 512 * it, t = item >> 4, hf = (item >> 3) & 1, p8 = item & 7, i1 = hf * 128 + p8 * 8;
            const size_t off = (size_t)(row0 + t) * 1024 + h * 256 + i1;
            const u32x4 q1 = *(const u32x4*)(BQ + off), q2 = *(const u32x4*)(BQ + off + 64), k1 = *(const u32x4*)(BK + off), k2 = *(const u32x4*)(BK + off + 64);
            const float pos = hf ? (float)t : (float)n_l;
#pragma unroll
            for (int e = 0; e < 8; ++e) {
                float cs = 1.f, sn = 0.f;
                if (is_lat) { const float ang = pos * exp2f(-(float)(p8 * 8 + e) * 0.20762050593046014f); cs = __cosf(ang); sn = __sinf(ang); }
                const unsigned uq1 = q1[e >> 1], uq2 = q2[e >> 1], uk1 = k1[e >> 1], uk2 = k2[e >> 1];
                const float a1 = (e & 1) ? bfhi(uq1) : bflo(uq1), a2 = (e & 1) ? bfhi(uq2) : bflo(uq2);
                const float b1 = (e & 1) ? bfhi(uk1) : bflo(uk1), b2 = (e & 1) ? bfhi(uk2) : bflo(uk2);
                qr[it][e] = (a1 * cs - a2 * sn) * 0.0625f; qr[it][8 + e] = (a1 * sn + a2 * cs) * 0.0625f;
                kr[it][e] = b1 * cs - b2 * sn; kr[it][8 + e] = b1 * sn + b2 * cs;
            }
        }
#pragma unroll 1
        for (int dir = 0; dir < 2; ++dir) {
            { const int idx = tid * 2, t = idx >> 4, r = idx & 15; *(f32x2*)(lr + idx) = *(const f32x2*)(BG + (size_t)(row0 + t) * 32 + dir * 16 + r); }
            { const int idx = tid * 4, r = idx >> 7, p = idx & 127; *(f32x4*)(w2s + idx) = *(const f32x4*)(a.w_gate2 + (size_t)(dir * 16 + r) * 512 + h * 128 + p); }
            if (tid < 128) bs[tid] = a.b_gate[dir * 512 + h * 128 + tid];
            __syncthreads();
            { const int p = tid & 127, tq = tid >> 7;
#pragma unroll 4
              for (int i = 0; i < 16; ++i) { const int t = tq + 4 * i; float z = bs[p];
#pragma unroll
                  for (int r = 0; r < 16; ++r) z += lr[t * 16 + r] * w2s[r * 128 + p];
                  G[t * 128 + p] = (fminf(z, 0.f) - __logf(1.f + __expf(-fabsf(z)))) * 0.0625f; } }
            __syncthreads();
            {
                const int p = tid & 127, seg = tid >> 7; float v[16]; float run = 0.f;
#pragma unroll
                for (int s = 0; s < 16; ++s) { const int sidx = seg * 16 + s, t = dir ? 63 - sidx : sidx; run += G[t * 128 + p]; v[s] = run; }
                float* segs = w2s;
                __syncthreads();
                segs[seg * 128 + p] = run;
                __syncthreads();
                float off = 0.f;
#pragma unroll
                for (int q = 0; q < 3; ++q) off += (q < seg) ? segs[q * 128 + p] : 0.f;
#pragma unroll
                for (int s = 0; s < 16; ++s) { const int sidx = seg * 16 + s, t = dir ? 63 - sidx : sidx; G[t * 128 + p] = v[s] + off; }
                if (seg == 3) lastv[p] = run + off;
            }
            __syncthreads();
            if (tid < 256) { const int p = (tid >> 7) * 64 + (tid & 63); DL[((size_t)(dir * 520 + gc) * 4 + h) * 256 + tid] = __expf(lastv[p]); }
            unsigned kdp[2][8];
#pragma unroll
            for (int it = 0; it < 2; ++it) {
                const int item = tid + 512 * it, t = item >> 4, hf = (item >> 3) & 1, p8 = item & 7, i1 = hf * 128 + p8 * 8, gcol = hf * 64 + p8 * 8;
                float qe[16], ke[16], kd[16];
#pragma unroll
                for (int e = 0; e < 8; ++e) { const float cum = G[t * 128 + gcol + e], lst = lastv[gcol + e];
                    const float eq = __expf(cum), ek = __expf(-cum), ed = __expf(lst - cum);
                    qe[e] = qr[it][e] * eq; qe[8 + e] = qr[it][8 + e] * eq; ke[e] = kr[it][e] * ek; ke[8 + e] = kr[it][8 + e] * ek; kd[e] = kr[it][e] * ed; kd[8 + e] = kr[it][8 + e] * ed; }
                u32x4 w;
                w.x = pk2(qe[0], qe[1]); w.y = pk2(qe[2], qe[3]); w.z = pk2(qe[4], qe[5]); w.w = pk2(qe[6], qe[7]); *(u32x4*)(QEs + t * 264 + i1) = w;
                w.x = pk2(qe[8], qe[9]); w.y = pk2(qe[10], qe[11]); w.z = pk2(qe[12], qe[13]); w.w = pk2(qe[14], qe[15]); *(u32x4*)(QEs + t * 264 + i1 + 64) = w;
                w.x = pk2(ke[0], ke[1]); w.y = pk2(ke[2], ke[3]); w.z = pk2(ke[4], ke[5]); w.w = pk2(ke[6], ke[7]); *(u32x4*)(KEs + t * 264 + i1) = w;
                w.x = pk2(ke[8], ke[9]); w.y = pk2(ke[10], ke[11]); w.z = pk2(ke[12], ke[13]); w.w = pk2(ke[14], ke[15]); *(u32x4*)(KEs + t * 264 + i1 + 64) = w;
#pragma unroll
                for (int e = 0; e < 8; ++e) kdp[it][e] = pk2(kd[2 * e], kd[2 * e + 1]);
            }
            __syncthreads();
#pragma unroll
            for (int it = 0; it < 2; ++it) {
                const int item = tid + 512 * it, t = item >> 4, hf = (item >> 3) & 1, p8 = item & 7, i1 = hf * 128 + p8 * 8;
                u32x4 w; w.x = kdp[it][0]; w.y = kdp[it][1]; w.z = kdp[it][2]; w.w = kdp[it][3]; *(u32x4*)(KDs + t * 256 + i1) = w;
                w.x = kdp[it][4]; w.y = kdp[it][5]; w.z = kdp[it][6]; w.w = kdp[it][7]; *(u32x4*)(KDs + t * 256 + i1 + 64) = w;
            }
            if (is_lat) {
                const int mi = wave >> 1, nb = (wave & 1) * 2;
                f32x4 c0 = {0.f, 0.f, 0.f, 0.f}, c1 = c0;
#pragma unroll
                for (int ks = 0; ks < 8; ++ks) {
                    const bf16x8 A = *(const bf16x8*)(QEs + (16 * mi + q16) * 264 + ks * 32 + 8 * g);
                    const bf16x8 B0 = *(const bf16x8*)(KEs + (16 * nb + q16) * 264 + ks * 32 + 8 * g);
                    const bf16x8 B1 = *(const bf16x8*)(KEs + (16 * (nb + 1) + q16) * 264 + ks * 32 + 8 * g);
                    c0 = mfma16(A, B0, c0); c1 = mfma16(A, B1, c1);
                }
#pragma unroll
                for (int e = 0; e < 4; ++e) { const int t = 16 * mi + 4 * g + e;
                    bf16_t* ab = ATT + ((size_t)(dir * 512 + gc) * 4 + h) * 4096 + (size_t)((t >> 5) * 4) * 512 + (t & 31) * 8;
                    { const int tp = 16 * nb + q16; const bool keep = dir ? (tp >= t) : (tp <= t);
                      ab[(tp >> 4) * 512 + ((tp >> 3) & 1) * 256 + (tp & 7)] = (bf16_t)(pk2(keep ? c0[e] : 0.f, 0.f) & 0xffffu); }
                    { const int tp = 16 * (nb + 1) + q16; const bool keep = dir ? (tp >= t) : (tp <= t);
                      ab[(tp >> 4) * 512 + ((tp >> 3) & 1) * 256 + (tp & 7)] = (bf16_t)(pk2(keep ? c1[e] : 0.f, 0.f) & 0xffffu); }
                }
            }
            __syncthreads();
            if (is_lat) {
                bf16_t* QE = dir ? (bf16_t*)(a.ws + WS_AZ) : QEFdst;
#pragma unroll
                for (int j = 0; j < 4; ++j) { const int c = tid + 512 * j, t = c >> 5, ch = c & 31, blk = ch >> 2, s = (ch >> 1) & 1, hh = ch & 1, srcA = blk * 32 + 16 * s + 4 * hh;
                    const u32x2 lo = *(const u32x2*)(QEs + t * 264 + srcA), hi = *(const u32x2*)(QEs + t * 264 + srcA + 8);
                    u32x4 w; w.x = lo.x; w.y = lo.y; w.z = hi.x; w.w = hi.y;
                    const int slot = ((blk * 2 + (t >> 5)) * 2 + s) * 2 + hh;
                    *(u32x4*)(QE + (size_t)(row0 + slot) * 1024 + h * 256 + (t & 31) * 8) = w; }
            }
            { bf16_t* KDT = (bf16_t*)(a.ws + (dir ? WS_AVT : WS_AK));
#pragma unroll
              for (int j = 0; j < 4; ++j) { const int c = tid + 512 * j, dk = c >> 3, t8 = c & 7;
                  unsigned v[8];
#pragma unroll
                  for (int e = 0; e < 8; ++e) v[e] = KDs[(t8 * 8 + e) * 256 + dk];
                  u32x4 w; w.x = v[0] | (v[1] << 16); w.y = v[2] | (v[3] << 16); w.z = v[4] | (v[5] << 16); w.w = v[6] | (v[7] << 16);
                  *(u32x4*)(KDT + ((((size_t)gc * 4 + h) * 8 + (dk >> 5)) * 4 + (t8 >> 1)) * 512 + ((t8 & 1) * 32 + (dk & 31)) * 8) = w; } }
            __syncthreads();
        }
    }
}

__device__ __forceinline__ void phase_scan(const Args& a, unsigned char* smem, int tid, int lane, int wave) {
    unsigned* red = (unsigned*)smem;
    unsigned char* vst = smem + 65536;
    unsigned char* dst = smem + 73728;
    const int l31 = lane & 31, hh = lane >> 5, kb = wave;
    for (int wu = blockIdx.x; wu < 256; wu += gridDim.x) {
        const int combo = (wu & 7) * 2 + (wu >> 7), sl = (wu >> 3) & 15;
        const int b = combo >> 3, h = (combo >> 1) & 3, dir = combo & 1;
        const bf16_t* QE = (const bf16_t*)(a.ws + (dir ? WS_AZ : WS_BQ));
        const bf16_t* KDT = (const bf16_t*)(a.ws + (dir ? WS_AVT : WS_AK));
        const bf16_t* ATT = (const bf16_t*)(a.ws + WS_ATT) + (size_t)dir * 512 * 4 * 4096;
        const float* DL = (const float*)(a.ws + WS_DL) + (size_t)dir * 520 * 1024;
        const bf16_t* BVF = (const bf16_t*)(a.ws + WS_BVT) + (size_t)lane * 8;
        bf16_t* O = (bf16_t*)((unsigned char*)a.out + (dir ? DO_OB : DO_OF));
        f32x16 S;
#pragma unroll
        for (int i = 0; i < 16; ++i) S[i] = 0.f;
        bf16x8 vB[4], qeA[4], atA; f32x4 dl[4];
        bf16x8 nqe[4], nat;
        u32x4 gcur = {0u, 0u, 0u, 0u}, gnxt = {0u, 0u, 0u, 0u};
#define SCAN_GC(step) ((step) < 4 ? 512 + b * 4 + (dir ? 3 - (step) : (step)) : b * 256 + (dir ? 259 - (step) : (step) - 4))
#define SCAN_LOAD(step, QE_, AT_) do { const int gc_ = SCAN_GC(step); const size_t rq_ = gc_ < 512 ? (size_t)gc_ * 64 : 0; \
        _Pragma("unroll") for (int mt_ = 0; mt_ < 2; ++mt_) _Pragma("unroll") for (int s_ = 0; s_ < 2; ++s_) \
            QE_[mt_ * 2 + s_] = *(const bf16x8*)(QE + (rq_ + (((kb * 2 + mt_) * 2 + s_) * 2 + hh)) * 1024 + h * 256 + l31 * 8); \
        AT_ = *(const bf16x8*)(ATT + (((rq_ >> 6) * 4 + h) * 8 + wave) * 512 + lane * 8); } while (0)
#define SCAN_GLOAD(step, G_) do { const int gc_ = SCAN_GC(step); \
        if (wave < 4) G_ = *(const u32x4*)(BVF + ((((size_t)gc_ * 4 + h) * 16 + sl) * 4 + wave) * 512); \
        else if (wave == 4) G_ = *(const u32x4*)(DL + ((size_t)gc_ * 4 + h) * 256 + lane * 4); } while (0)
#define SCAN_GSTORE(buf, G_) do { if (wave < 4) *(u32x4*)(vst + (((buf) * 4 + wave) * 64 + lane) * 16) = G_; \
        else if (wave == 4) *(u32x4*)(dst + (buf) * 1024 + lane * 16) = G_; } while (0)
#define SCAN_LREAD(buf, VB_, DL_) do { _Pragma("unroll") for (int q_ = 0; q_ < 4; ++q_) { \
        VB_[q_] = *(const bf16x8*)(vst + (((buf) * 4 + q_) * 64 + lane) * 16); \
        DL_[q_] = *(const f32x4*)(dst + (buf) * 1024 + (kb * 32 + 8 * q_ + 4 * hh) * 4); } } while (0)
        const unsigned char* scb; unsigned scsg;
        { const int q16s = sl * 16 + (lane & 15);
          if (wave == 5) { if (lane < 16) { scb = (const unsigned char*)KDT + (size_t)h * 32768 + (size_t)q16s * 128; scsg = 131072u; }
                           else if (lane < 32) { scb = (const unsigned char*)QE + (size_t)h * 512 + (size_t)(q16s >> 2) * 2048 + (q16s & 3) * 128; scsg = 131072u; }
                           else if (lane < 36) { scb = (const unsigned char*)ATT + (size_t)h * 8192 + (size_t)(sl * 4 + lane - 32) * 128; scsg = 32768u; }
                           else { scb = (const unsigned char*)DL + (size_t)h * 1024 + (lane & 7) * 128; scsg = 4096u; } }
          else if (wave == 6) { scb = (const unsigned char*)(a.ws + WS_BVT) + (size_t)(h * 16 + sl) * 4096 + (size_t)(lane & 31) * 128; scsg = 262144u; }
          else { scb = (const unsigned char*)DL + (size_t)h * 1024; scsg = 0u; } }
        unsigned scA = 0u, scB = 0u;
        __syncthreads();
        SCAN_GLOAD(0, gcur); SCAN_GSTORE(0, gcur);
        SCAN_GLOAD(1, gcur);
        SCAN_LOAD(0, qeA, atA);
        __syncthreads();
        SCAN_LREAD(0, vB, dl);
        __builtin_amdgcn_s_waitcnt(0x0F70);
        auto stepf = [&](const int step, unsigned& sc_issue, unsigned& sc_consume) __attribute__((always_inline)) {
            const int nstep = step < 259 ? step + 1 : step, n2 = step < 258 ? step + 2 : 259;
            SCAN_LOAD(nstep, nqe, nat);
            SCAN_GLOAD(n2, gnxt);
#if SCOUT
            { int ss = step + SCOUT; ss = ss > 259 ? 259 : ss; const int gcs = SCAN_GC(ss); sc_issue = *(const unsigned*)(scb + (size_t)gcs * scsg); }
#endif
            const int gc = SCAN_GC(step); const size_t row0 = (size_t)gc * 64;
            bf16x8 kdA[4];
            { const bf16_t* kp = KDT + (((size_t)gc * 4 + h) * 8 + kb) * 2048 + lane * 8;
#pragma unroll
              for (int q = 0; q < 4; ++q) kdA[q] = *(const bf16x8*)(kp + 512 * q); }
            const int rbuf = step & 1, nbuf = rbuf ^ 1;
            if (gc < 512) {
                u32x4 s0, s1;
                s0.x = pk2(S[0], S[1]); s0.y = pk2(S[2], S[3]); s0.z = pk2(S[4], S[5]); s0.w = pk2(S[6], S[7]);
                s1.x = pk2(S[8], S[9]); s1.y = pk2(S[10], S[11]); s1.z = pk2(S[12], S[13]); s1.w = pk2(S[14], S[15]);
                const bf16x8 sb0 = __builtin_bit_cast(bf16x8, s0), sb1 = __builtin_bit_cast(bf16x8, s1);
                f32x16 o0, o1;
#pragma unroll
                for (int i = 0; i < 16; ++i) { o0[i] = 0.f; o1[i] = 0.f; }
                o0 = mfma32(qeA[0], sb0, o0); o0 = mfma32(qeA[1], sb1, o0);
                o1 = mfma32(qeA[2], sb0, o1); o1 = mfma32(qeA[3], sb1, o1);
                const int w3 = wave & 3;
                const bf16x8 vs = w3 == 0 ? vB[0] : (w3 == 1 ? vB[1] : (w3 == 2 ? vB[2] : vB[3]));
                if (wave < 4) o0 = mfma32(atA, vs, o0); else o1 = mfma32(atA, vs, o1);
                unsigned* rb = red + (size_t)(rbuf * 8 + wave) * 1024 + lane; unsigned* rbx = red + (size_t)(rbuf * 8 + wave) * 1024 + (lane ^ 32);
#pragma unroll
                for (int i = 0; i < 8; ++i) { unsigned* w_ = (i & 1) ? rbx : rb; w_[i * 64] = pk2(o0[2 * i], o0[2 * i + 1]); w_[512 + i * 64] = pk2(o1[2 * i], o1[2 * i + 1]); }
            }
            SCAN_GSTORE(nbuf, gcur);
            __syncthreads();
            if (gc < 512) {
                const int tp = tid >> 4, dv2 = (tid & 15) * 2, t = tp * 2, mt = t >> 5, tl = t & 31, pi = 2 * (tl >> 3) + ((tl & 3) >> 1), ln = ((tl >> 2) & 1) * 32 + dv2;
                const unsigned* rp = red + (size_t)rbuf * 8192 + (mt * 8 + pi) * 64 + (ln ^ ((pi & 1) << 5));
                float a0 = 0.f, a1 = 0.f, b0 = 0.f, b1 = 0.f;
#pragma unroll
                for (int w = 0; w < 8; ++w) { const u32x2 v = *(const u32x2*)(rp + w * 1024); a0 += bflo(v.x); b0 += bfhi(v.x); a1 += bflo(v.y); b1 += bfhi(v.y); }
                bf16_t* op = O + (row0 + t) * 2048 + h * 512 + sl * 32 + dv2;
                *(unsigned*)op = pk2(a0, a1); *(unsigned*)(op + 2048) = pk2(b0, b1);
            }
            f32x4 ndl[4]; bf16x8 nvB[4];
            SCAN_LREAD(nbuf, nvB, ndl);
#pragma unroll
            for (int i = 0; i < 16; ++i) S[i] *= dl[i >> 2][i & 3];
#pragma unroll
            for (int ks = 0; ks < 4; ++ks) S = mfma32(kdA[ks], vB[ks], S);
#pragma unroll
            for (int i = 0; i < 4; ++i) { vB[i] = nvB[i]; dl[i] = ndl[i]; qeA[i] = nqe[i]; }
            atA = nat; gcur = gnxt;
#if SCOUT
            asm volatile("" :: "v"(sc_consume));
#endif
        };
#pragma unroll 1
        for (int step = 0; step < 260; step += 2) { stepf(step, scA, scB); stepf(step + 1, scB, scA); }
        asm volatile("" :: "v"(scA), "v"(scB));
        __syncthreads();
#undef SCAN_LREAD
#undef SCAN_GSTORE
#undef SCAN_GLOAD
#undef SCAN_LOAD
#undef SCAN_GC
    }
}

__device__ __forceinline__ void phase_ybz(const Args& a, int lane, int wave) {
    const bf16_t* OF = (const bf16_t*)((unsigned char*)a.out + DO_OF); const bf16_t* OB = (const bf16_t*)((unsigned char*)a.out + DO_OB);
    bf16_t* BZ = (bf16_t*)(a.ws + WS_BZ);
    const f32x4 g0 = *(const f32x4*)(a.norm_g + lane * 8), g1 = *(const f32x4*)(a.norm_g + lane * 8 + 4);
    const int NW = gridDim.x * 8;
    for (int it0 = blockIdx.x * 8 + wave; it0 < MLAT * 4; it0 += 4 * NW) {
        u32x4 f[4], bb[4], z[4]; size_t off[4];
#pragma unroll
        for (int k = 0; k < 4; ++k) { const int it = min(it0 + k * NW, MLAT * 4 - 1); off[k] = (size_t)(it >> 2) * 2048 + (it & 3) * 512 + lane * 8;
            f[k] = __builtin_nontemporal_load((const u32x4*)(OF + off[k])); bb[k] = __builtin_nontemporal_load((const u32x4*)(OB + off[k])); z[k] = __builtin_nontemporal_load((const u32x4*)(BZ + off[k])); }
#pragma unroll
        for (int k = 0; k < 4; ++k) {
            float o[8]; float ss = 0.f;
#pragma unroll
            for (int e = 0; e < 4; ++e) { o[2 * e] = bflo(f[k][e]) + bflo(bb[k][e]); o[2 * e + 1] = bfhi(f[k][e]) + bfhi(bb[k][e]); }
#pragma unroll
            for (int e = 0; e < 8; ++e) ss += o[e] * o[e];
            const float rs = rsqrtf(wave_sum(ss) * (1.f / 512.f) + 1e-6f);
            u32x4 w;
            w.x = pk2(o[0] * rs * g0[0] * silu_f(bflo(z[k].x)), o[1] * rs * g0[1] * silu_f(bfhi(z[k].x)));
            w.y = pk2(o[2] * rs * g0[2] * silu_f(bflo(z[k].y)), o[3] * rs * g0[3] * silu_f(bfhi(z[k].y)));
            w.z = pk2(o[4] * rs * g1[0] * silu_f(bflo(z[k].z)), o[5] * rs * g1[1] * silu_f(bfhi(z[k].z)));
            w.w = pk2(o[6] * rs * g1[2] * silu_f(bflo(z[k].w)), o[7] * rs * g1[3] * silu_f(bfhi(z[k].w)));
            if (it0 + k * NW < MLAT * 4) *(u32x4*)(BZ + off[k]) = w;
        }
    }
}

__device__ __forceinline__ void phase_ln(const Args& a, int lane, int wave) {
    const bf16_t* R = (const bf16_t*)(a.ws + WS_BQ);
    for (int r = blockIdx.x * 8 + wave; r < MLAT; r += gridDim.x * 8) {
        const u32x2* rr = (const u32x2*)(R + (size_t)r * 2048) + lane;
        f32x4* xr = (f32x4*)(a.out + (size_t)r * 2048) + lane;
        u32x2 w[8]; f32x4 v[8]; float s = 0.f;
#pragma unroll
        for (int q = 0; q < 8; ++q) w[q] = __builtin_nontemporal_load(rr + 64 * q);
#pragma unroll
        for (int q = 0; q < 8; ++q) { { const f32x2 p0 = unpkh2(w[q].x), p1 = unpkh2(w[q].y); v[q] = (f32x4){p0.x, p0.y, p1.x, p1.y}; } s += (v[q].x + v[q].y) + (v[q].z + v[q].w); }
        const float mean = wave_sum(s) * (1.f / 2048.f); float s2 = 0.f;
#pragma unroll
        for (int q = 0; q < 8; ++q) { v[q] = v[q] - mean; s2 += (v[q].x * v[q].x + v[q].y * v[q].y) + (v[q].z * v[q].z + v[q].w * v[q].w); }
        const float rstd = rsqrtf(wave_sum(s2) * (1.f / 2048.f) + 1e-6f);
        const f32x4* gg = (const f32x4*)a.ln_g + lane; const f32x4* bb = (const f32x4*)a.ln_b + lane;
#pragma unroll
        for (int q = 0; q < 8; ++q) __builtin_nontemporal_store(v[q] * rstd * gg[64 * q] + bb[64 * q], xr + 64 * q);
    }
}

#define LAS __attribute__((address_space(3)))
#define XB_TMO      128
#define XB_XCNT(j)  (256  + 64 * (j))
#define XB_XSUB(j)  (1280 + 64 * (j))
#define XB_XGEN(j)  (2304 + 64 * (j))
#define XB_TOP      3328
#define XB_TOPGEN   3392
#define XCD_BAR_WORDS 3456
#define XB_SPIN_CAP (1u << 18)

__device__ __forceinline__ unsigned xb_ld(unsigned* p)              { return __hip_atomic_load(p, __ATOMIC_RELAXED, __HIP_MEMORY_SCOPE_AGENT); }
__device__ __forceinline__ unsigned xb_add(unsigned* p, unsigned v) { return __hip_atomic_fetch_add(p, v, __ATOMIC_RELAXED, __HIP_MEMORY_SCOPE_AGENT); }
__device__ __forceinline__ unsigned xb_xcc_id() { return (unsigned)__builtin_amdgcn_s_getreg((3 << 11) | 20) & 0xFu; }
#define XB_SPIN(cond, bar) do { unsigned _sp = 0; while (cond) { __builtin_amdgcn_s_sleep(1); \
    if ((++_sp & 255u) == 0u) { if (xb_ld(&(bar)[XB_TMO])) break; if (_sp > XB_SPIN_CAP) { atomicAdd(&(bar)[XB_TMO], 1u); break; } } } } while (0)

struct XcdBarrier {
    unsigned* bar; unsigned x;
    volatile LAS unsigned* st;
};

__device__ __forceinline__ XcdBarrier xcd_barrier_post(unsigned* bar, volatile LAS unsigned* st) {
    XcdBarrier b; b.bar = bar; b.x = xb_xcc_id(); b.st = st;
    if (threadIdx.x == 0) (void)xb_add(&bar[XB_XCNT(b.x)], 1u);
    return b;
}
__device__ __forceinline__ void xcd_barrier_complete(unsigned* bar, unsigned x, unsigned& nloc, unsigned& nx) {
    const unsigned G = gridDim.x * gridDim.y * gridDim.z;
    unsigned sum, cnt, mine, sp = 0u;
    for (;;) {
        sum = 0u; cnt = 0u; mine = 0u;
#pragma unroll
        for (unsigned j = 0; j < 16; ++j) { const unsigned c = xb_ld(&bar[XB_XCNT(j)]); sum += c; cnt += (c > 0u) ? 1u : 0u; mine = (j == x) ? c : mine; }
        if (sum == G) break;
        __builtin_amdgcn_s_sleep(1);
        if ((++sp & 255u) == 0u) { if (xb_ld(&bar[XB_TMO])) break; if (sp > XB_SPIN_CAP) { atomicAdd(&bar[XB_TMO], 1u); break; } }
    }
    nloc = mine > 0u ? mine : 1u; nx = cnt > 0u ? cnt : 1u;
}

__device__ __forceinline__ void xcd_barrier(const XcdBarrier& b) {
    asm volatile("s_waitcnt vmcnt(0)" ::: "memory");
    __syncthreads();
    if (threadIdx.x == 0) {
        unsigned* bar = b.bar;
        __builtin_amdgcn_s_waitcnt(0);
        unsigned nloc = b.st[0], nx = b.st[1];
        if (nloc == 0u) { xcd_barrier_complete(bar, b.x, nloc, nx); b.st[0] = nloc; b.st[1] = nx; }
        const unsigned old = xb_add(&bar[XB_XSUB(b.x)], 1u);
        const unsigned gen = old / nloc;
        if (old + 1u == (gen + 1u) * nloc) {
            __builtin_amdgcn_fence(__ATOMIC_RELEASE, "agent");
            asm volatile("s_waitcnt vmcnt(0)" ::: "memory");
            const unsigned og = xb_add(&bar[XB_TOP], 1u);
            const unsigned tg = og / nx;
            if (og + 1u == (tg + 1u) * nx) xb_add(&bar[XB_TOPGEN], 1u);
            else XB_SPIN(xb_ld(&bar[XB_TOPGEN]) == tg, bar);
            __builtin_amdgcn_fence(__ATOMIC_ACQUIRE, "agent");
            xb_add(&bar[XB_XGEN(b.x)], 1u);
            asm volatile("s_waitcnt vmcnt(0)" ::: "memory");
        } else {
            XB_SPIN(xb_ld(&bar[XB_XGEN(b.x)]) == gen, bar);
            __builtin_amdgcn_fence(__ATOMIC_ACQUIRE, "agent");
            asm volatile("s_waitcnt vmcnt(0)" ::: "memory");
        }
    }
    __syncthreads();
}

__global__ void __launch_bounds__(512, 2) mk_fwd(Args a) {
    extern __shared__ __attribute__((aligned(16))) unsigned char smem[];
    const int tid = threadIdx.x, lane = tid & 63, wave = __builtin_amdgcn_readfirstlane(tid >> 6);
    const int lo = a.ph_lo, hi = a.ph_hi;
#define IN(k) (lo <= (k) && (k) < hi)
#define SEAM(k) do { if (IN(k) && IN((k) + 1)) { xcd_barrier(xbar); } } while (0)
    PG8_LAS unsigned char* ring = (PG8_LAS unsigned char*)smem;
    volatile LAS unsigned* xst = (volatile LAS unsigned*)((LAS unsigned char*)smem + 147440);
    if (tid < 4) xst[tid] = 0u;
    __syncthreads();
    XcdBarrier xbar = xcd_barrier_post((unsigned*)(a.ws + WS_XBAR), xst);
    if (a.ph_hi > 1000) cg::this_grid().sync();
    if (IN(0)) { phase0(a, smem, tid, lane, wave); }
    SEAM(0);
    if (IN(1)) { phase1(a, smem, tid, lane, wave); if (PROBE_P1 > 1) { __syncthreads(); phase1(a, smem, tid, lane, wave); } }
    SEAM(1);
    if (IN(2)) {
        pg8::Gemm g{(const bf16_t*)((unsigned char*)a.out + DO_H), (const bf16_t*)((unsigned char*)a.out + DO_WIN), MR, NPROJ, 2048};
        pg8::StaticOrder S; S.init(MR, NPROJ, gridDim.x, (int)blockIdx.x);
        EpiProj E{a.ws, smem + 131072};
        pg8::gemm_phase<EpiProj, pg8::StaticOrder, PG8_ALIGN, PG8_SP2>(ring, g, S, E);
        if (PROBE_P2 > 1) { __syncthreads(); pg8::gemm_phase<EpiProj, pg8::StaticOrder, PG8_ALIGN, PG8_SP2>(ring, g, S, E); }
    }
    SEAM(2);
    if (IN(3)) { for (int rep = 0; rep < PROBE_P3D; ++rep) { phase_attn(a, smem, tid, lane, wave, (bf16_t*)a.out); __syncthreads(); }
                 phase_attn(a, smem, tid, lane, wave, (bf16_t*)(a.ws + WS_AQ)); }
    SEAM(3);
    if (IN(4)) { for (int rep = 0; rep < PROBE_P4D; ++rep) { phase_g0(a, smem, tid, lane, wave, (bf16_t*)a.out); __syncthreads(); }
                 phase_g0(a, smem, tid, lane, wave, (bf16_t*)(a.ws + WS_BQ)); }
    SEAM(4);
    if (IN(5)) { for (int rep = 0; rep < PROBE_P5; ++rep) { phase_scan(a, smem, tid, lane, wave); __syncthreads(); } }
    SEAM(5);
    if (IN(6)) { phase_ybz(a, lane, wave); }
    SEAM(6);
    if (IN(7)) {
        pg8::StaticOrder S; S.init(MLAT, 2048, gridDim.x, (int)blockIdx.x);
        { pg8::Gemm g{(const bf16_t*)(a.ws + WS_AQ), (const bf16_t*)(a.ws + WS_WA), MLAT, 2048, 1024};
          EpiMerge1 E{(bf16_t*)(a.ws + WS_MGA)};
          pg8::gemm_phase<EpiMerge1, pg8::StaticOrder, PG8_ALIGN, PG8_SP2>(ring, g, S, E); }
        __syncthreads();
        { pg8::Gemm g{(const bf16_t*)(a.ws + WS_BZ), (const bf16_t*)(a.ws + WS_WB), MLAT, 2048, 2048};
          EpiMerge2 E{(const bf16_t*)(a.ws + WS_MGA), (const bf16_t*)(a.ws + WS_MGB), (bf16_t*)(a.ws + WS_AK)};
          pg8::gemm_phase<EpiMerge2, pg8::StaticOrder, PG8_ALIGN, PG8_SP2>(ring, g, S, E); }
    }
    SEAM(7);
    if (IN(8)) {
        pg8::Gemm g{(const bf16_t*)(a.ws + WS_AK), (const bf16_t*)(a.ws + WS_WO), MLAT, 2048, 2048};
        pg8::StaticOrder S; S.init(MLAT, 2048, gridDim.x, (int)blockIdx.x);
        EpiOut E{a.x, (const float*)(a.ws + WS_MOD), a.b_mod, (bf16_t*)(a.ws + WS_BQ)};
        pg8::gemm_phase<EpiOut, pg8::StaticOrder, PG8_ALIGN, PG8_SP2>(ring, g, S, E);
        if (PROBE_P8 > 1) { __syncthreads(); pg8::gemm_phase<EpiOut, pg8::StaticOrder, PG8_ALIGN, PG8_SP2>(ring, g, S, E); }
    }
    SEAM(8);
    if (IN(9)) { for (int i = 0; i < PROBE_SYNC; ++i) xcd_barrier(xbar);
                 phase_ln(a, lane, wave); }
#undef IN
#undef SEAM
}

extern "C" void kernel_launch(void* const* d_in, const int* in_sizes, int n_in, void* d_out, int out_size, void* d_ws, size_t ws_size, hipStream_t stream) {
    static int grid = 0;
    if (grid == 0) {
        if (n_in != 16 || out_size != MLAT * 2048 || ws_size < WS_END) { fprintf(stderr, "kernel_launch: unexpected shapes (n_in %d out %d ws %zu need %zu)\n", n_in, out_size, ws_size, (size_t)WS_END); grid = -1; return; }
        int dev = 0, cus = 0, per_cu = 0;
        hipGetDevice(&dev); hipDeviceGetAttribute(&cus, hipDeviceAttributeMultiprocessorCount, dev);
        if (hipFuncSetAttribute((const void*)mk_fwd, hipFuncAttributeMaxDynamicSharedMemorySize, LDS_BYTES) != hipSuccess) { fprintf(stderr, "kernel_launch: hipFuncSetAttribute failed\n"); grid = -1; return; }
        if (hipOccupancyMaxActiveBlocksPerMultiprocessor(&per_cu, (const void*)mk_fwd, 512, LDS_BYTES) != hipSuccess || per_cu < 1) { fprintf(stderr, "kernel_launch: occupancy query says %d\n", per_cu); per_cu = 1; }
        (void)hipGetLastError();
        grid = cus * 1;
    }
    if (grid < 0) return;
    (void)hipMemsetAsync((char*)d_ws + WS_MOD, 0, 163840, stream);
    Args a{};
    a.x = (const float*)d_in[0]; a.c = (const float*)d_in[1]; a.ctx = (const float*)d_in[2]; a.c_ctx = (const float*)d_in[3];
    a.w_mod = (const float*)d_in[4]; a.b_mod = (const float*)d_in[5]; a.w_in = (const float*)d_in[6]; a.na_rpb = (const float*)d_in[7];
    a.w_gate2 = (const float*)d_in[8]; a.b_gate = (const float*)d_in[9]; a.norm_g = (const float*)d_in[10]; a.w_br_a = (const float*)d_in[11];
    a.w_br_b = (const float*)d_in[12]; a.w_out = (const float*)d_in[13]; a.ln_g = (const float*)d_in[14]; a.ln_b = (const float*)d_in[15];
    a.out = (float*)d_out; a.ws = (unsigned char*)d_ws;
#if MK_MULTI
    for (int p = 0; p < NPHASE; ++p) { a.ph_lo = p; a.ph_hi = p + 1; hipLaunchKernelGGL(mk_fwd, dim3(grid), dim3(512), LDS_BYTES, stream, a); }
#else
    a.ph_lo = 0; a.ph_hi = NPHASE;
    void* args[] = {&a};
    hipError_t e = hipLaunchCooperativeKernel((const void*)mk_fwd, dim3(grid), dim3(512), args, LDS_BYTES, stream);
    if (e != hipSuccess) fprintf(stderr, "kernel_launch: cooperative launch failed: %s (grid %d)\n", hipGetErrorString(e), grid);
#endif
}
```
